# Optimizing an MI355X kernel written in HIP

```python
import math
import jax, jax.numpy as jnp
from jax import lax
import numpy as np

D_MODEL = 1024
BATCH = 1
SEQ = 16384
DEPTH = 4

N_MIXERS = 4
N_MEM = 256
HEAD_DIM = 64
MEM_HEADS = 4
MEM_WIDTH = MEM_HEADS * HEAD_DIM
MLA_HEADS = 12
MLA_Q_LORA = 384
MLA_KV_LORA = 256
MLA_NOPE = 64
MLA_ROPE = 32
MLA_V = 64
ROPE_THETA = 10000.0
Q_BLOCK = 128
A_IN = MLA_Q_LORA + MLA_KV_LORA + MLA_ROPE + MEM_WIDTH
A_OUT = MLA_HEADS * MLA_V + MEM_WIDTH
DIL_GROUPS = ((128, 1), (512, 4), (2048, 16))
DIL_HEADS = 8
DIL_BLOCK = 64
DIL_QKV = len(DIL_GROUPS) * 3 * DIL_HEADS * HEAD_DIM
B_IN = DIL_QKV + MEM_WIDTH
B_OUT = DIL_HEADS * HEAD_DIM + MEM_WIDTH
ALIBI_MAX = 8.0
CONV_CH = 768
CONV_WIDTH = 31
C_IN = 2 * CONV_CH + MEM_WIDTH
C_OUT = CONV_CH + MEM_WIDTH
SC_CH = 768
SC_WIDTH = 3
D_IN = 3 * SC_CH + MEM_WIDTH
D_OUT = SC_CH + MEM_WIDTH
D_FF = 2816
EPS = 1e-6
NEG = -1e30

kernel_name = "hybrid_interleaved_mla_dilated_conformer_shortconv_encoder"


def _n_uses(m):
    return len(range(m, DEPTH, N_MIXERS))


def rms_norm(x, g):
    xf = x.astype(jnp.float32)
    y = xf * lax.rsqrt(jnp.mean(xf * xf, axis=-1, keepdims=True) + EPS)
    return (y * g.astype(jnp.float32)).astype(x.dtype)


def layer_norm(x, g, b):
    xf = x.astype(jnp.float32)
    mu = jnp.mean(xf, axis=-1, keepdims=True)
    var = jnp.mean(jnp.square(xf - mu), axis=-1, keepdims=True)
    y = (xf - mu) * lax.rsqrt(var + EPS)
    return (y * g.astype(jnp.float32) + b.astype(jnp.float32)).astype(x.dtype)


def swiglu(h, wg, wu, wd):
    return jnp.einsum('bsf,fd->bsd', jax.nn.silu(h @ wg) * (h @ wu), wd)


def depthwise_conv(u, w):
    width, ch = w.shape
    return lax.conv_general_dilated(
        u, w[:, None, :].astype(u.dtype), window_strides=(1,),
        padding=[(width // 2, width // 2)],
        dimension_numbers=('NWC', 'WIO', 'NWC'), feature_group_count=ch)


def alibi_slopes(n):
    return 2.0 ** (-ALIBI_MAX * (jnp.arange(n, dtype=jnp.float32) + 1.0) / n)


def apply_rope(t, cos, sin):
    if t.ndim == 4:
        cos, sin = cos[:, :, None, :], sin[:, :, None, :]
    half = t.shape[-1] // 2
    tf = t.astype(jnp.float32)
    t1, t2 = tf[..., :half], tf[..., half:]
    return jnp.concatenate([t1 * cos - t2 * sin, t1 * sin + t2 * cos], axis=-1).astype(t.dtype)


def memory_attention(q_mem, mem_n, w_kv):
    bsz, seq, _ = q_mem.shape
    kv = (mem_n @ w_kv).reshape(bsz, mem_n.shape[1], 2, MEM_HEADS, HEAD_DIM)
    k, v = kv[:, :, 0], kv[:, :, 1]
    q = q_mem.reshape(bsz, seq, MEM_HEADS, HEAD_DIM)
    s = jnp.einsum('bshd,bnhd->bhsn', q, k).astype(jnp.float32) * HEAD_DIM ** -0.5
    p = jax.nn.softmax(s, axis=-1).astype(v.dtype)
    return jnp.einsum('bhsn,bnhd->bshd', p, v).reshape(bsz, seq, MEM_WIDTH)


def mla_mixer(h, positions, w_in, q_g, kv_g, w_uq, w_ukv):
    bsz, seq, _ = h.shape
    z = h @ w_in
    o1 = MLA_Q_LORA
    o2 = o1 + MLA_KV_LORA
    o3 = o2 + MLA_ROPE
    c_q, c_kv, k_r, q_mem = z[..., :o1], z[..., o1:o2], z[..., o2:o3], z[..., o3:]
    half = MLA_ROPE // 2
    inv = ROPE_THETA ** (-jnp.arange(half, dtype=jnp.float32) / half)
    ang = positions.astype(jnp.float32)[..., None] * inv
    cos, sin = jnp.cos(ang), jnp.sin(ang)
    q = (rms_norm(c_q, q_g) @ w_uq).reshape(bsz, seq, MLA_HEADS, MLA_NOPE + MLA_ROPE)
    q_n, q_r = q[..., :MLA_NOPE], apply_rope(q[..., MLA_NOPE:], cos, sin)
    kv = (rms_norm(c_kv, kv_g) @ w_ukv).reshape(bsz, seq, MLA_HEADS, MLA_NOPE + MLA_V)
    k_n, v = kv[..., :MLA_NOPE], kv[..., MLA_NOPE:]
    k_r = apply_rope(k_r, cos, sin)
    scale = (MLA_NOPE + MLA_ROPE) ** -0.5
    nb = seq // Q_BLOCK
    qn_b = q_n.reshape(bsz, nb, Q_BLOCK, MLA_HEADS, MLA_NOPE).transpose(1, 0, 2, 3, 4)
    qr_b = q_r.reshape(bsz, nb, Q_BLOCK, MLA_HEADS, MLA_ROPE).transpose(1, 0, 2, 3, 4)

    def block(args):
        qn, qr = args
        s = (jnp.einsum('bqhd,bkhd->bhqk', qn, k_n)
             + jnp.einsum('bqhr,bkr->bhqk', qr, k_r)).astype(jnp.float32) * scale
        p = jax.nn.softmax(s, axis=-1).astype(v.dtype)
        return jnp.einsum('bhqk,bkhd->bqhd', p, v)

    o = lax.map(block, (qn_b, qr_b))
    o = o.transpose(1, 0, 2, 3, 4).reshape(bsz, seq, MLA_HEADS * MLA_V)
    return o, q_mem


def dilated_group(q, k, v, dilation, half, slopes):
    bsz, seq, nh, dh = q.shape
    sub_len = seq // dilation
    nb = -(-sub_len // DIL_BLOCK)
    lp = nb * DIL_BLOCK

    def sub(t):
        return t.reshape(bsz, sub_len, dilation, nh, dh).transpose(0, 2, 1, 3, 4)

    qs = jnp.pad(sub(q), ((0, 0), (0, 0), (0, lp - sub_len), (0, 0), (0, 0)))
    qs = qs.reshape(bsz, dilation, nb, DIL_BLOCK, nh, dh)

    def kv_blocks(t):
        t = jnp.pad(sub(t), ((0, 0), (0, 0), (DIL_BLOCK, lp - sub_len + DIL_BLOCK), (0, 0), (0, 0)))
        t = t.reshape(bsz, dilation, nb + 2, DIL_BLOCK, nh, dh)
        return jnp.concatenate([t[:, :, :-2], t[:, :, 1:-1], t[:, :, 2:]], axis=3)

    kb, vb = kv_blocks(k), kv_blocks(v)
    qi = jnp.arange(DIL_BLOCK)
    kj = jnp.arange(3 * DIL_BLOCK)
    rel = kj[None, :] - DIL_BLOCK - qi[:, None]
    key_idx = jnp.arange(nb)[:, None] * DIL_BLOCK - DIL_BLOCK + kj[None, :]
    mask = (jnp.abs(rel) <= half)[None] & ((key_idx >= 0) & (key_idx < sub_len))[:, None, :]
    dist = (jnp.abs(rel) * dilation).astype(jnp.float32)
    s = jnp.einsum('brnqhd,brnkhd->brnhqk', qs, kb).astype(jnp.float32) * dh ** -0.5
    s = s - slopes[:, None, None] * dist
    s = jnp.where(mask[:, None], s, NEG)
    lse = jax.nn.logsumexp(s, axis=-1)
    p = jnp.exp(s - lse[..., None]).astype(v.dtype)
    o = jnp.einsum('brnhqk,brnkhd->brnqhd', p, vb)
    o = o.reshape(bsz, dilation, lp, nh, dh)[:, :, :sub_len]
    o = o.transpose(0, 2, 1, 3, 4).reshape(bsz, seq, nh, dh)
    lse = lse.transpose(0, 1, 2, 4, 3).reshape(bsz, dilation, lp, nh)[:, :, :sub_len]
    lse = lse.transpose(0, 2, 1, 3).reshape(bsz, seq, nh)
    return o, lse


def dilated_mixer(h, w_in):
    bsz, seq, _ = h.shape
    z = h @ w_in
    n_g = len(DIL_GROUPS)
    zd = z[..., :DIL_QKV].reshape(bsz, seq, n_g, 3, DIL_HEADS, HEAD_DIM)
    q_mem = z[..., DIL_QKV:]
    slopes = alibi_slopes(n_g * DIL_HEADS).reshape(n_g, DIL_HEADS)
    outs, lses = [], []
    for g, (window, dilation) in enumerate(DIL_GROUPS):
        o, l = dilated_group(zd[:, :, g, 0], zd[:, :, g, 1], zd[:, :, g, 2],
                             dilation, window // (2 * dilation), slopes[g])
        outs.append(o)
        lses.append(l)
    wts = jax.nn.softmax(jnp.stack(lses, axis=0), axis=0)
    o = jnp.einsum('gbsh,gbshd->bshd', wts.astype(outs[0].dtype), jnp.stack(outs, axis=0))
    return o.reshape(bsz, seq, DIL_HEADS * HEAD_DIM), q_mem


def conformer_conv_mixer(h, w_in, conv_w, conv_b, ln_g, ln_b):
    z = h @ w_in
    a, gate, q_mem = z[..., :CONV_CH], z[..., CONV_CH:2 * CONV_CH], z[..., 2 * CONV_CH:]
    u = a * jax.nn.sigmoid(gate)
    u = depthwise_conv(u, conv_w) + conv_b
    u = jax.nn.silu(layer_norm(u, ln_g, ln_b))
    return u, q_mem


def short_conv_mixer(h, w_in, conv_w):
    z = h @ w_in
    bg, cg = z[..., :SC_CH], z[..., SC_CH:2 * SC_CH]
    hx, q_mem = z[..., 2 * SC_CH:3 * SC_CH], z[..., 3 * SC_CH:]
    return bg * depthwise_conv(cg * hx, conv_w), q_mem


def setup_inputs(seed: int = 0) -> dict:
    key = jax.random.key(seed)
    ks = jax.random.split(key, 32)
    f32 = jnp.float32

    def w(k, shape, fan_in):
        return jax.random.normal(k, shape, f32) * fan_in ** -0.5

    def gain(k, shape):
        return 1.0 + 0.05 * jax.random.normal(k, shape, f32)

    na, nb_, nc, nd = _n_uses(0), _n_uses(1), _n_uses(2), _n_uses(3)
    offset = jax.random.randint(ks[2], (BATCH, 1), 0, 4096, dtype=jnp.int32)
    positions = offset + jnp.arange(SEQ, dtype=jnp.int32)[None, :]
    return {
        "x": jax.random.normal(ks[0], (BATCH, SEQ, D_MODEL), f32),
        "mem": jax.random.normal(ks[1], (BATCH, N_MEM, D_MODEL), f32),
        "positions": positions,
        "norm_g": gain(ks[3], (DEPTH, 7, D_MODEL)),
        "ffn_w_gate": w(ks[4], (DEPTH, 2, D_MODEL, D_FF), D_MODEL),
        "ffn_w_up": w(ks[5], (DEPTH, 2, D_MODEL, D_FF), D_MODEL),
        "ffn_w_down": w(ks[6], (DEPTH, 2, D_FF, D_MODEL), D_FF),
        "mem_w_kv": w(ks[7], (DEPTH, D_MODEL, 2 * MEM_WIDTH), D_MODEL),
        "a_w_in": w(ks[8], (na, D_MODEL, A_IN), D_MODEL),
        "a_q_norm": gain(ks[9], (na, MLA_Q_LORA)),
        "a_kv_norm": gain(ks[10], (na, MLA_KV_LORA)),
        "a_w_uq": w(ks[11], (na, MLA_Q_LORA, MLA_HEADS * (MLA_NOPE + MLA_ROPE)), MLA_Q_LORA),
        "a_w_ukv": w(ks[12], (na, MLA_KV_LORA, MLA_HEADS * (MLA_NOPE + MLA_V)), MLA_KV_LORA),
        "a_w_out": w(ks[13], (na, A_OUT, D_MODEL), A_OUT),
        "b_w_in": w(ks[14], (nb_, D_MODEL, B_IN), D_MODEL),
        "b_w_out": w(ks[15], (nb_, B_OUT, D_MODEL), B_OUT),
        "c_w_in": w(ks[16], (nc, D_MODEL, C_IN), D_MODEL),
        "c_conv_w": w(ks[17], (nc, CONV_WIDTH, CONV_CH), CONV_WIDTH),
        "c_conv_b": 0.02 * jax.random.normal(ks[18], (nc, CONV_CH), f32),
        "c_ln_g": gain(ks[19], (nc, CONV_CH)),
        "c_ln_b": 0.02 * jax.random.normal(ks[20], (nc, CONV_CH), f32),
        "c_w_out": w(ks[21], (nc, C_OUT, D_MODEL), C_OUT),
        "d_w_in": w(ks[22], (nd, D_MODEL, D_IN), D_MODEL),
        "d_conv_w": w(ks[23], (nd, SC_WIDTH, SC_CH), SC_WIDTH),
        "d_w_out": w(ks[24], (nd, D_OUT, D_MODEL), D_OUT),
    }


def reference(x, mem, positions, norm_g, ffn_w_gate, ffn_w_up, ffn_w_down, mem_w_kv,
              a_w_in, a_q_norm, a_kv_norm, a_w_uq, a_w_ukv, a_w_out,
              b_w_in, b_w_out,
              c_w_in, c_conv_w, c_conv_b, c_ln_g, c_ln_b, c_w_out,
              d_w_in, d_conv_w, d_w_out):
    for i in range(DEPTH):
        g = norm_g[i]
        h = rms_norm(x, g[0])
        x = x + 0.5 * rms_norm(swiglu(h, ffn_w_gate[i, 0], ffn_w_up[i, 0], ffn_w_down[i, 0]), g[1])
        h = rms_norm(x, g[2])
        m, j = i % N_MIXERS, i // N_MIXERS
        if m == 0:
            o, q_mem = mla_mixer(h, positions, a_w_in[j], a_q_norm[j], a_kv_norm[j], a_w_uq[j], a_w_ukv[j])
            w_out = a_w_out[j]
        elif m == 1:
            o, q_mem = dilated_mixer(h, b_w_in[j])
            w_out = b_w_out[j]
        elif m == 2:
            o, q_mem = conformer_conv_mixer(h, c_w_in[j], c_conv_w[j], c_conv_b[j], c_ln_g[j], c_ln_b[j])
            w_out = c_w_out[j]
        else:
            o, q_mem = short_conv_mixer(h, d_w_in[j], d_conv_w[j])
            w_out = d_w_out[j]
        mo = memory_attention(q_mem, rms_norm(mem, g[6]), mem_w_kv[i])
        y = jnp.concatenate([o, mo], axis=-1) @ w_out
        x = x + rms_norm(y, g[3])
        h = rms_norm(x, g[4])
        x = x + 0.5 * rms_norm(swiglu(h, ffn_w_gate[i, 1], ffn_w_up[i, 1], ffn_w_down[i, 1]), g[5])
    return x
```

```cpp
#include <hip/hip_runtime.h>
#include <hip/hip_cooperative_groups.h>
#include <cstdio>
#include <cstdint>
namespace cg = cooperative_groups;

#ifndef MK_MULTI_LAUNCH
#define MK_MULTI_LAUNCH 0
#endif

#define LAS __attribute__((address_space(3)))
typedef unsigned short bf16_t;
typedef short bf16x8 __attribute__((ext_vector_type(8)));
typedef short s16x4 __attribute__((ext_vector_type(4)));
typedef float f32x2 __attribute__((ext_vector_type(2)));
typedef float f32x4 __attribute__((ext_vector_type(4)));
typedef float f32x16 __attribute__((ext_vector_type(16)));
typedef unsigned u32x2 __attribute__((ext_vector_type(2)));
typedef unsigned u32x4 __attribute__((ext_vector_type(4)));
typedef __bf16 bf2_t __attribute__((ext_vector_type(2)));
#define DI __device__ __forceinline__

constexpr int S = 16384, DM = 1024, FF = 2816;
constexpr float EPS = 1e-6f;
constexpr float LOG2E = 1.4426950408889634f;
constexpr int NWAVES = 8, NTHREADS = 512;
constexpr int LDS_BYTES = 147456;

constexpr size_t MiB = 1ull << 20;
constexpr size_t WS_CS = 0;
constexpr size_t WS_RINVQ = 2 * MiB;
constexpr size_t WS_RINVK = 2 * MiB + 65536;
constexpr size_t WS_MEMK = 2 * MiB + 131072;
constexpr size_t WS_MEMVT = 2 * MiB + 262144;
constexpr size_t WS_MEMN = 2 * MiB + 524288;
constexpr size_t WS_KR = 3 * MiB;
constexpr size_t WS_LSE = 4 * MiB;
constexpr size_t WS_WGU = 6 * MiB;
constexpr size_t WS_WD = 28 * MiB;
constexpr size_t WS_WIN = 39 * MiB;
constexpr size_t WS_WOUT = 49 * MiB;
constexpr size_t WS_WUQ = 51 * MiB;
constexpr size_t WS_WUKV = 52 * MiB;
constexpr size_t WS_WMKV = 53 * MiB;
constexpr size_t WS_HB = 54 * MiB;
constexpr size_t WS_CAT = 86 * MiB;
constexpr size_t WS_AUX = 118 * MiB;
constexpr size_t WS_Z = 166 * MiB;
constexpr size_t WS_END = 318 * MiB;
constexpr size_t ZO_Y = 88 * MiB, ZO_Q = 32 * MiB, ZO_KN = 72 * MiB, ZO_VT = 96 * MiB;

enum { K_P0 = 0, K_PREP, K_MEMKV, K_GU, K_DOWN, K_ROW, K_INPROJ, K_MLASTAT, K_MEMATT, K_UPQ, K_UPK, K_UPV, K_MLAATT, K_DILATT, K_MERGE, K_CONV, K_SCONV, K_OUTPROJ };
struct OpTable { unsigned v[96]; int n; };
constexpr OpTable make_ops() {
    OpTable t{}; int n = 0;
    auto add = [&](int k, int L, int f, int sync) { t.v[n++] = (unsigned)k | ((unsigned)L << 8) | ((unsigned)f << 16) | ((unsigned)sync << 24); };
    add(K_P0, 0, 0, 0); add(K_PREP, 0, 0, 1);
    for (int L = 0; L < 4; ++L) {
        add(K_MEMKV, L, 0, 0); add(K_GU, L, 0, 1); add(K_DOWN, L, 0, 1); add(K_ROW, L, 0, 1);
        add(K_INPROJ, L, 0, 1);
        if (L == 0) { add(K_MLASTAT, L, 0, 0); add(K_MEMATT, L, 0, 1); add(K_UPQ, L, 0, 0); add(K_UPK, L, 0, 0); add(K_UPV, L, 0, 1); add(K_MLAATT, L, 0, 1); }
        if (L == 1) { add(K_DILATT, L, 0, 0); add(K_MEMATT, L, 0, 1); add(K_MERGE, L, 0, 1); }
        if (L == 2) { add(K_CONV, L, 0, 0); add(K_MEMATT, L, 0, 1); }
        if (L == 3) { add(K_SCONV, L, 0, 0); add(K_MEMATT, L, 0, 1); }
        add(K_OUTPROJ, L, 0, 1); add(K_ROW, L, 1, 1);
        add(K_GU, L, 1, 1); add(K_DOWN, L, 1, 1);
        if (L < 3) { add(K_ROW, L, 2, 0); add(K_PREP, L + 1, 0, 1); } else add(K_ROW, L, 2, 1);
    }
    t.n = n; return t;
}
constexpr OpTable H_OPS = make_ops();
__constant__ OpTable D_OPS = make_ops();

__constant__ float INVF[16] = {1.000000000e+00f, 5.623413324e-01f, 3.162277639e-01f, 1.778279394e-01f, 1.000000015e-01f, 5.623413250e-02f, 3.162277490e-02f, 1.778279431e-02f,
                               9.999999776e-03f, 5.623413250e-03f, 3.162277630e-03f, 1.778279431e-03f, 1.000000047e-03f, 5.623413017e-04f, 3.162277571e-04f, 1.778279402e-04f};

DI unsigned pk2(float lo, float hi) { f32x2 v = {lo, hi}; bf2_t r = __builtin_convertvector(v, bf2_t); return __builtin_bit_cast(unsigned, r); }
DI float bf2f(unsigned short b) { return __uint_as_float(((unsigned)b) << 16); }
DI float bflo(unsigned w) { return __uint_as_float(w << 16); }
DI float bfhi(unsigned w) { return __uint_as_float(w & 0xffff0000u); }
DI float wave_sum(float v) {
#pragma unroll
    for (int o = 1; o < 64; o <<= 1) v += __shfl_xor(v, o);
    return v;
}
DI float fexp2(float x) { return __builtin_amdgcn_exp2f(x); }
DI float frcp(float x) { return __builtin_amdgcn_rcpf(x); }
DI float silu_f(float g) { return g * frcp(1.f + fexp2(-g * LOG2E)); }
DI float sigmoid_f(float g) { return frcp(1.f + fexp2(-g * LOG2E)); }

namespace pg8 {
constexpr int BM = 256, BK = 64, HALF = 128, HTB = HALF * BK * 2, STAGE_BYTES = 8 * HTB, NXCD = 8, WGM = 8;
DI int lds_byte(int r, int c) { const int st = (r >> 4) * 2 + (c >> 5), rr = r & 15, cc = c & 31, ob = rr * 64 + cc * 2; return st * 1024 + (ob ^ (((ob >> 9) & 1) << 5)); }
DI void stage_rc(int b, int& R, int& C) { const int st = b / 1024, sb = b % 1024, swz = sb ^ (((sb >> 9) & 1) << 5); R = (st >> 1) * 16 + swz / 64; C = (st & 1) * 32 + (swz % 64) / 2; }
DI int perm32(int rho) { const int n = rho >> 4, i = rho & 15; return 8 * (i >> 2) + 4 * n + (i & 3); }

struct Unit { int pm, pn; };
struct Gemm { const bf16_t* A; const bf16_t* Bt; int M, N, K, lda, ldb; };

struct StaticOrder {
    int nM, nN, nwg, G, c;
    DI void init(int M, int N, int G_, int c_) { nM = M / BM; nN = N / BM; nwg = nM * nN; G = G_; c = c_; }
    DI bool next(int i, Unit& u) const {
        const long L = (long)i * G + c; if (L >= nwg) return false;
        int wgid = (int)L; { const int q = nwg / NXCD, r = nwg % NXCD, xcd = wgid % NXCD, off = wgid / NXCD; wgid = (xcd < r ? xcd * (q + 1) : r * (q + 1) + (xcd - r) * q) + off; }
        const int nig = WGM * nN, gid = wgid / nig, fm = gid * WGM, gsz = (nM - fm) < WGM ? (nM - fm) : WGM;
        u.pm = fm + ((wgid % nig) % gsz); u.pn = (wgid % nig) / gsz; return true;
    }
};


struct EpiF32 {
    static constexpr bool PERM = false;
    float* O; int ldc;
    DI void operator()(const f32x4 (&acc)[2][2][4][2], const Unit& u, int wr, int wc, int fr, int fq) const {
        const int row0 = u.pm * BM + wr * 64 + fr, col0 = u.pn * BM + wc * 32 + 4 * fq;
#pragma unroll
        for (int ai = 0; ai < 2; ++ai)
#pragma unroll
            for (int m = 0; m < 4; ++m) { float* rowp = O + (size_t)(row0 + ai * HALF + m * 16) * ldc + col0;
#pragma unroll
                for (int bj = 0; bj < 2; ++bj)
#pragma unroll
                    for (int n = 0; n < 2; ++n) *(f32x4*)(rowp + bj * HALF + n * 16) = acc[ai][bj][m][n];
                asm volatile("" ::: "memory"); }
    }
};

struct EpiPair {
    static constexpr bool PERM = true;
    bf16_t* O; int ldc, lo, hi, op; const float* rowscale;
    DI void operator()(const f32x4 (&acc)[2][2][4][2], const Unit& u, int wr, int wc, int fr, int fq) const {
        const int row0 = u.pm * BM + wr * 64 + fr;
        const bool paired = (u.pn >= lo && u.pn < hi);
        const int colbase = u.pn < lo ? 256 * u.pn : (u.pn < hi ? 256 * lo + 128 * (u.pn - lo) : 256 * lo + 128 * (hi - lo) + 256 * (u.pn - hi));
        const int col0 = colbase + wc * 32 + 8 * fq;
#pragma unroll
        for (int ai = 0; ai < 2; ++ai)
#pragma unroll
            for (int m = 0; m < 4; ++m) {
                const int r = row0 + ai * HALF + m * 16;
                bf16_t* rowp = O + (size_t)r * ldc + col0;
                if (paired) {
                    float a[8], b[8], v[8];
#pragma unroll
                    for (int e = 0; e < 4; ++e) { a[e] = acc[ai][0][m][0][e]; a[4 + e] = acc[ai][0][m][1][e]; b[e] = acc[ai][1][m][0][e]; b[4 + e] = acc[ai][1][m][1][e]; }
                    if (op == 0) {
#pragma unroll
                        for (int e = 0; e < 8; ++e) v[e] = silu_f(a[e]) * b[e];
                    } else if (op == 1) {
#pragma unroll
                        for (int e = 0; e < 8; ++e) v[e] = a[e] * sigmoid_f(b[e]);
                    } else {
#pragma unroll
                        for (int e = 0; e < 8; ++e) v[e] = a[e] * b[e];
                    }
                    u32x4 w; w.x = pk2(v[0], v[1]); w.y = pk2(v[2], v[3]); w.z = pk2(v[4], v[5]); w.w = pk2(v[6], v[7]);
                    *(u32x4*)rowp = w;
                } else {
                    const float rs = rowscale ? rowscale[r] : 1.f;
#pragma unroll
                    for (int bj = 0; bj < 2; ++bj) { const f32x4 v0 = acc[ai][bj][m][0] * rs, v1 = acc[ai][bj][m][1] * rs;
                        u32x4 w; w.x = pk2(v0[0], v0[1]); w.y = pk2(v0[2], v0[3]); w.z = pk2(v1[0], v1[1]); w.w = pk2(v1[2], v1[3]);
                        *(u32x4*)(rowp + bj * HALF) = w; }
                }
            }
    }
};

struct EpiQ {
    static constexpr bool PERM = true;
    bf16_t* O; int ldc; const float* rowscale; const f32x4* cs;
    DI void operator()(const f32x4 (&acc)[2][2][4][2], const Unit& u, int wr, int wc, int fr, int fq) const {
        const int row0 = u.pm * BM + wr * 64 + fr;
        const float sgn = (fq < 2) ? -1.f : 1.f;
#pragma unroll
        for (int ai = 0; ai < 2; ++ai)
#pragma unroll
            for (int m = 0; m < 4; ++m) {
                const int r = row0 + ai * HALF + m * 16;
                const float rs = rowscale[r];
                bf16_t* rowp = O + (size_t)r * ldc + u.pn * BM + wc * 32 + 8 * fq;
#pragma unroll
                for (int bj = 0; bj < 2; ++bj) {
                    const int cgp = 8 * u.pn + 4 * bj + wc;
                    const bool rope = (cgp < 36) && (cgp % 3 == 2);
                    float v[8];
#pragma unroll
                    for (int e = 0; e < 4; ++e) { v[e] = acc[ai][bj][m][0][e] * rs; v[4 + e] = acc[ai][bj][m][1][e] * rs; }
                    if (rope) {
                        const f32x4* cp = cs + (size_t)r * 8 + 4 * (fq & 1);
#pragma unroll
                        for (int e2 = 0; e2 < 4; ++e2) { const f32x4 c4 = cp[e2];
                            const float p0 = __shfl_xor(v[2 * e2], 32), p1 = __shfl_xor(v[2 * e2 + 1], 32);
                            v[2 * e2] = v[2 * e2] * c4[0] + sgn * p0 * c4[1]; v[2 * e2 + 1] = v[2 * e2 + 1] * c4[2] + sgn * p1 * c4[3]; }
                    }
                    u32x4 w; w.x = pk2(v[0], v[1]); w.y = pk2(v[2], v[3]); w.z = pk2(v[4], v[5]); w.w = pk2(v[6], v[7]);
                    *(u32x4*)(rowp + bj * HALF) = w;
                }
                asm volatile("" ::: "memory");
            }
    }
};

struct EpiColScale {
    static constexpr bool PERM = true;
    bf16_t* O; int ldc; const float* colscale;
    DI void operator()(const f32x4 (&acc)[2][2][4][2], const Unit& u, int wr, int wc, int fr, int fq) const {
        const int row0 = u.pm * BM + wr * 64 + fr;
        const int col0 = u.pn * BM + wc * 32 + 8 * fq;
        const f32x4 s00 = *(const f32x4*)(colscale + col0), s01 = *(const f32x4*)(colscale + col0 + 4);
        const f32x4 s10 = *(const f32x4*)(colscale + col0 + HALF), s11 = *(const f32x4*)(colscale + col0 + HALF + 4);
#pragma unroll
        for (int ai = 0; ai < 2; ++ai)
#pragma unroll
            for (int m = 0; m < 4; ++m) {
                bf16_t* rowp = O + (size_t)(row0 + ai * HALF + m * 16) * ldc + col0;
#pragma unroll
                for (int bj = 0; bj < 2; ++bj) {
                    const f32x4 v0 = acc[ai][bj][m][0] * (bj ? s10 : s00), v1 = acc[ai][bj][m][1] * (bj ? s11 : s01);
                    u32x4 w; w.x = pk2(v0[0], v0[1]); w.y = pk2(v0[2], v0[3]); w.z = pk2(v1[0], v1[1]); w.w = pk2(v1[2], v1[3]);
                    *(u32x4*)(rowp + bj * HALF) = w;
                }
                asm volatile("" ::: "memory");
            }
    }
};

struct EpiMemKV {
    static constexpr bool PERM = true;
    bf16_t* Kp; bf16_t* Vt;
    DI void operator()(const f32x4 (&acc)[2][2][4][2], const Unit& u, int wr, int wc, int fr, int fq) const {
        const int row0 = wr * 64 + fr, c0 = wc * 32 + 8 * fq;
#pragma unroll
        for (int ai = 0; ai < 2; ++ai)
#pragma unroll
            for (int m = 0; m < 4; ++m) {
                const int r = row0 + ai * HALF + m * 16;
#pragma unroll
                for (int bj = 0; bj < 2; ++bj) {
                    const f32x4 v0 = acc[ai][bj][m][0], v1 = acc[ai][bj][m][1];
                    if (u.pn == 0) {
                        u32x4 w; w.x = pk2(v0[0], v0[1]); w.y = pk2(v0[2], v0[3]); w.z = pk2(v1[0], v1[1]); w.w = pk2(v1[2], v1[3]);
                        *(u32x4*)(Kp + (size_t)r * 256 + c0 + bj * HALF) = w;
                    } else {
                        bf16_t* vp = Vt + (size_t)(c0 + bj * HALF) * 256 + r;
#pragma unroll
                        for (int e = 0; e < 4; ++e) { vp[e * 256] = (bf16_t)(pk2(v0[e], 0.f) & 0xffffu); vp[(4 + e) * 256] = (bf16_t)(pk2(v1[e], 0.f) & 0xffffu); }
                    }
                }
                asm volatile("" ::: "memory");
            }
    }
};

template <class Epi>
DI void gemm_phase(LAS unsigned char* lds, const Gemm g, const StaticOrder& S, const Epi& E, const int tid) {
    const int wid = __builtin_amdgcn_readfirstlane(tid >> 6), lane = tid & 63, wr = wid >> 2, wc = wid & 3, fr = lane & 15, fq = lane >> 4;
    int K = g.K; asm volatile("" : "+s"(K));
    const int nt = K / BK;
    unsigned voffA[2], voffB[2];
#pragma unroll
    for (int i = 0; i < 2; ++i) { int R, C; stage_rc(tid * 16 + i * 8192, R, C); const int Rb = Epi::PERM ? ((R & ~31) + perm32(R & 31)) : R;
        voffA[i] = (unsigned)(R * g.lda + C) * 2u; voffB[i] = (unsigned)(Rb * g.ldb + C) * 2u; }
    const size_t kstep = (size_t)(BK * 2);
    const size_t hstepA = (size_t)HALF * g.lda * 2, tstepA = 2 * hstepA;
    const size_t hstepB = (size_t)HALF * g.ldb * 2, tstepB = 2 * hstepB;
    const unsigned ldsw = (unsigned)wid * 1024u;
    const int aoff = lds_byte(wr * 64 + fr, fq * 8), boff = lds_byte(wc * 32 + fr, fq * 8);
#define PG8_SA(b, h) (((b) * 2 + (h)) * HTB)
#define PG8_SB(b, h) ((4 + (b) * 2 + (h)) * HTB)
#define PG8_STAGE(bufoff, gbase, voff) do { _Pragma("unroll") for (int _i = 0; _i < 2; ++_i) \
        __builtin_amdgcn_global_load_lds((const unsigned*)((const char*)(gbase) + (voff)[_i]), (LAS unsigned*)(lds + (bufoff) + ldsw + _i * 8192), 16, 0, 0); } while (0)
#define PG8_LDA(dst, b, h) do { _Pragma("unroll") for (int m = 0; m < 4; ++m) _Pragma("unroll") for (int k = 0; k < 2; ++k) dst[m][k] = *(const LAS bf16x8*)(lds + PG8_SA(b, h) + aoff + m * 2048 + k * 1024); } while (0)
#define PG8_LDB(dst, b, h) do { _Pragma("unroll") for (int n = 0; n < 2; ++n) _Pragma("unroll") for (int k = 0; k < 2; ++k) dst[n][k] = *(const LAS bf16x8*)(lds + PG8_SB(b, h) + boff + n * 2048 + k * 1024); } while (0)
#define PG8_MMA(ai, bj, At, Bt) do { __builtin_amdgcn_s_setprio(1); _Pragma("unroll") for (int m = 0; m < 4; ++m) _Pragma("unroll") for (int n = 0; n < 2; ++n) _Pragma("unroll") for (int k = 0; k < 2; ++k) \
        acc[ai][bj][m][n] = __builtin_amdgcn_mfma_f32_16x16x32_bf16(Bt[n][k], At[m][k], acc[ai][bj][m][n], 0, 0, 0); __builtin_amdgcn_s_setprio(0); } while (0)
#define PG8_WAIT_V(n) asm volatile("s_waitcnt vmcnt(" #n ")" ::: "memory")
#define PG8_WAIT_L(n) asm volatile("s_waitcnt lgkmcnt(" #n ")" ::: "memory")
#define PG8_BAR __builtin_amdgcn_s_barrier()
#define PG8_SCHED __builtin_amdgcn_sched_barrier(0)
    Unit cur, nxt; int ui = 0;
    if (!S.next(0, cur)) return;
    f32x4 acc[2][2][4][2];
#pragma unroll
    for (int a = 0; a < 2; ++a)
#pragma unroll
        for (int b = 0; b < 2; ++b)
#pragma unroll
            for (int m = 0; m < 4; ++m)
#pragma unroll
                for (int n = 0; n < 2; ++n) acc[a][b][m][n] = (f32x4){0.f, 0.f, 0.f, 0.f};
    bf16x8 At[4][2], B0[2][2], B1[2][2];
    const char* cA = (const char*)g.A + (size_t)cur.pm * tstepA; const char* cB = (const char*)g.Bt + (size_t)cur.pn * tstepB;
    PG8_STAGE(PG8_SB(0, 0), cB, voffB); PG8_STAGE(PG8_SB(0, 1), cB + hstepB, voffB); PG8_STAGE(PG8_SA(0, 0), cA, voffA); PG8_STAGE(PG8_SA(0, 1), cA + hstepA, voffA);
    if (wr == 1) PG8_BAR;
    PG8_WAIT_V(2); PG8_BAR;
    PG8_STAGE(PG8_SB(1, 0), cB + kstep, voffB); PG8_STAGE(PG8_SA(1, 0), cA + kstep, voffA); PG8_STAGE(PG8_SB(1, 1), cB + hstepB + kstep, voffB);
    PG8_WAIT_V(6); PG8_BAR;
    for (;;) {
        const bool has_next = S.next(ui + 1, nxt);
        const char* nA = has_next ? (const char*)g.A + (size_t)nxt.pm * tstepA : cA; const char* nB = has_next ? (const char*)g.Bt + (size_t)nxt.pn * tstepB : cB;
        for (int t = 0; t < nt; t += 2) {
            const bool last = (t == nt - 2);
            const char* a1 = cA + (size_t)(t + 1) * kstep;
            const char* a2 = last ? nA : cA + (size_t)(t + 2) * kstep; const char* b2 = last ? nB : cB + (size_t)(t + 2) * kstep;
            const char* a3 = a2 + kstep; const char* b3 = b2 + kstep;
            PG8_LDB(B0, 0, 0); PG8_LDB(B1, 0, 1); PG8_SCHED; PG8_LDA(At, 0, 0); PG8_STAGE(PG8_SA(1, 1), a1 + hstepA, voffA);
            PG8_WAIT_V(8); PG8_WAIT_L(0); PG8_BAR; PG8_MMA(0, 0, At, B0); PG8_MMA(0, 1, At, B1); PG8_BAR; PG8_SCHED;
            PG8_LDA(At, 0, 1); PG8_STAGE(PG8_SB(0, 0), b2, voffB); PG8_STAGE(PG8_SB(0, 1), b2 + hstepB, voffB); PG8_STAGE(PG8_SA(0, 0), a2, voffA);
            PG8_WAIT_V(8); PG8_WAIT_L(0); PG8_BAR; PG8_MMA(1, 0, At, B0); PG8_MMA(1, 1, At, B1); PG8_BAR; PG8_SCHED;
            PG8_LDB(B0, 1, 0); PG8_LDB(B1, 1, 1); PG8_SCHED; PG8_LDA(At, 1, 0); PG8_STAGE(PG8_SA(0, 1), a2 + hstepA, voffA);
            PG8_WAIT_V(8); PG8_WAIT_L(0); PG8_BAR; PG8_MMA(0, 0, At, B0); PG8_MMA(0, 1, At, B1); PG8_BAR; PG8_SCHED;
            PG8_LDA(At, 1, 1); PG8_STAGE(PG8_SB(1, 0), b3, voffB); PG8_STAGE(PG8_SB(1, 1), b3 + hstepB, voffB); PG8_STAGE(PG8_SA(1, 0), a3, voffA);
            PG8_WAIT_V(8); PG8_WAIT_L(0); PG8_BAR; PG8_MMA(1, 0, At, B0); PG8_MMA(1, 1, At, B1); PG8_BAR; PG8_SCHED;
        }
        if (wr == 0) PG8_BAR;
        { int fr2 = fr, fq2 = fq; asm volatile("" : "+v"(fr2), "+v"(fq2)); E(acc, cur, wr, wc, fr2, fq2); }
        if (!has_next) break;
#pragma unroll
        for (int a = 0; a < 2; ++a)
#pragma unroll
            for (int b = 0; b < 2; ++b)
#pragma unroll
                for (int m = 0; m < 4; ++m)
#pragma unroll
                    for (int n = 0; n < 2; ++n) acc[a][b][m][n] = (f32x4){0.f, 0.f, 0.f, 0.f};
        cur = nxt; cA = nA; cB = nB; ++ui;
        if (wr == 1) PG8_BAR;
    }
    PG8_WAIT_V(0);
    PG8_BAR;
#undef PG8_SA
#undef PG8_SB
#undef PG8_STAGE
#undef PG8_LDA
#undef PG8_LDB
#undef PG8_MMA
#undef PG8_WAIT_V
#undef PG8_WAIT_L
#undef PG8_BAR
#undef PG8_SCHED
}
}

#define MFMA32(a, b, c) __builtin_amdgcn_mfma_f32_32x32x16_bf16((a), (b), (c), 0, 0, 0)
template <int KS, class SF>
DI void attn_tile(const LAS unsigned char* Kt, const int kstr, const LAS unsigned char* Vt, const int vstr,
                  const bf16x8 (&qf)[KS], f32x16 (&o)[2], float& m, float& l, const int l32, const int hl, SF sf) {
    f32x16 st[2];
#pragma unroll
    for (int kb = 0; kb < 2; ++kb) {
        f32x16 a;
#pragma unroll
        for (int i = 0; i < 16; ++i) a[i] = 0.f;
        const LAS unsigned char* kp = Kt + (32 * kb + l32) * kstr + 16 * hl;
#pragma unroll
        for (int s = 0; s < KS; ++s) a = MFMA32(*(const LAS bf16x8*)(kp + 32 * s), qf[s], a);
        st[kb] = a;
    }
    float mx = -INFINITY;
#pragma unroll
    for (int kb = 0; kb < 2; ++kb)
#pragma unroll
        for (int j = 0; j < 16; ++j) { const float v = sf(st[kb][j], 32 * kb + (j & 3) + 8 * (j >> 2) + 4 * hl); st[kb][j] = v; mx = fmaxf(mx, v); }
    mx = fmaxf(mx, __shfl_xor(mx, 32));
    const float mn = fmaxf(m, mx);
    const float ms = (mn == -INFINITY) ? 0.f : mn;
    const float alpha = fexp2(m - ms);
    float ps = 0.f;
#pragma unroll
    for (int kb = 0; kb < 2; ++kb)
#pragma unroll
        for (int j = 0; j < 16; ++j) { const float p = fexp2(st[kb][j] - ms); st[kb][j] = p; ps += p; }
    ps += __shfl_xor(ps, 32);
    l = l * alpha + ps; m = mn;
#pragma unroll
    for (int db = 0; db < 2; ++db)
#pragma unroll
        for (int i = 0; i < 16; ++i) o[db][i] *= alpha;
#pragma unroll
    for (int kb = 0; kb < 2; ++kb)
#pragma unroll
        for (int s2 = 0; s2 < 2; ++s2) {
            u32x4 pw;
            pw.x = pk2(st[kb][8 * s2 + 0], st[kb][8 * s2 + 1]); pw.y = pk2(st[kb][8 * s2 + 2], st[kb][8 * s2 + 3]);
            pw.z = pk2(st[kb][8 * s2 + 4], st[kb][8 * s2 + 5]); pw.w = pk2(st[kb][8 * s2 + 6], st[kb][8 * s2 + 7]);
            const bf16x8 pb = __builtin_bit_cast(bf16x8, pw);
#pragma unroll
            for (int db = 0; db < 2; ++db) {
                const LAS unsigned char* vp = Vt + (32 * db + l32) * vstr + (32 * kb + 16 * s2 + 4 * hl) * 2;
                const s16x4 lo = *(const LAS s16x4*)vp, hi = *(const LAS s16x4*)(vp + 16);
                const bf16x8 va = __builtin_shufflevector(lo, hi, 0, 1, 2, 3, 4, 5, 6, 7);
                o[db] = MFMA32(va, pb, o[db]);
            }
        }
}
DI void attn_store(bf16_t* orow, const f32x16 (&o)[2], const float inv, const int hl) {
#pragma unroll
    for (int db = 0; db < 2; ++db)
#pragma unroll
        for (int gq = 0; gq < 4; ++gq) { u32x2 w; w.x = pk2(o[db][4 * gq] * inv, o[db][4 * gq + 1] * inv); w.y = pk2(o[db][4 * gq + 2] * inv, o[db][4 * gq + 3] * inv);
            *(u32x2*)(orow + 32 * db + 8 * gq + 4 * hl) = w; }
}

struct Args { const void* in[25]; float* out; unsigned char* ws; int lo, hi; };

DI void row_op(const float* xin, float* xout, const float* Y, const float* gA, const float sc, const float* gB, bf16_t* hb, const int lane) {
    f32x4 v[4];
#pragma unroll
    for (int j = 0; j < 4; ++j) v[j] = ((const f32x4*)xin)[lane + 64 * j];
    if (Y) {
        f32x4 y[4]; float ss = 0.f;
#pragma unroll
        for (int j = 0; j < 4; ++j) { y[j] = ((const f32x4*)Y)[lane + 64 * j]; ss += (y[j][0] * y[j][0] + y[j][1] * y[j][1]) + (y[j][2] * y[j][2] + y[j][3] * y[j][3]); }
        ss = wave_sum(ss);
        const float ri = sc / sqrtf(ss * (1.f / 1024.f) + EPS);
#pragma unroll
        for (int j = 0; j < 4; ++j) { const f32x4 gv = ((const f32x4*)gA)[lane + 64 * j]; v[j] += y[j] * gv * ri; }
    }
    if (xout) {
#pragma unroll
        for (int j = 0; j < 4; ++j) ((f32x4*)xout)[lane + 64 * j] = v[j];
    }
    if (gB) {
        float ss = 0.f;
#pragma unroll
        for (int j = 0; j < 4; ++j) ss += (v[j][0] * v[j][0] + v[j][1] * v[j][1]) + (v[j][2] * v[j][2] + v[j][3] * v[j][3]);
        ss = wave_sum(ss);
        const float ri = 1.f / sqrtf(ss * (1.f / 1024.f) + EPS);
#pragma unroll
        for (int j = 0; j < 4; ++j) { const f32x4 gv = ((const f32x4*)gB)[lane + 64 * j]; const f32x4 ov = v[j] * gv * ri;
            u32x2 w; w.x = pk2(ov[0], ov[1]); w.y = pk2(ov[2], ov[3]); ((u32x2*)hb)[lane + 64 * j] = w; }
    }
}

DI int map_row(const int kind, const int nr) {
    if (kind == 0) return nr;
    if (kind == 1) return 256 * (nr >> 7) + (nr & 127);
    const int h = nr >> 7, w = nr & 127; return (w < 64) ? 64 * h + w : 768 + 64 * h + (w - 64);
}
DI void xpose_seg(const float* W, const int ldw, const int K, const int col0, const int ncols, bf16_t* WT, const int ldt, const int drow0, const int kind,
                  const float* gain, LAS float* scr, int& base, const int gw, const int NGW, const int lane) {
    const int nblk = ncols >> 5, nitems = (K >> 6) * nblk;
    int start = (gw - (base % NGW) + NGW) % NGW;
    for (int it = start; it < nitems; it += NGW) {
        const int kb = it / nblk, nb = it - kb * nblk, k0 = 64 * kb, n0 = 32 * nb;
#pragma unroll 8
        for (int i = 0; i < 32; ++i) { const int kk = 2 * i + (lane >> 5); float w = W[(size_t)(k0 + kk) * ldw + col0 + n0 + (lane & 31)]; if (gain) w *= gain[k0 + kk]; scr[kk * 33 + (lane & 31)] = w; }
        asm volatile("s_waitcnt lgkmcnt(0)" ::: "memory");
        const int c = lane & 7;
#pragma unroll
        for (int j = 0; j < 4; ++j) { const int n = (lane >> 3) + 8 * j; const LAS float* s = scr + (8 * c) * 33 + n;
            u32x4 o; o.x = pk2(s[0 * 33], s[1 * 33]); o.y = pk2(s[2 * 33], s[3 * 33]); o.z = pk2(s[4 * 33], s[5 * 33]); o.w = pk2(s[6 * 33], s[7 * 33]);
            *(u32x4*)(WT + (size_t)(drow0 + map_row(kind, n0 + n)) * ldt + k0 + 8 * c) = o; }
        asm volatile("s_waitcnt lgkmcnt(0)" ::: "memory");
    }
    base += nitems;
}

__global__ void __launch_bounds__(NTHREADS, 2) fwd_megakernel(Args args) {
    extern __shared__ __attribute__((aligned(16))) unsigned char lds_raw[];
    LAS unsigned char* lds = (LAS unsigned char*)lds_raw;
    cg::grid_group grid = cg::this_grid();
    const int G = gridDim.x;
    const int wave_s = __builtin_amdgcn_readfirstlane((int)(threadIdx.x >> 6));
#define xres (args.out)
#define in_x ((const float*)args.in[0])
#define in_mem ((const float*)args.in[1])
#define in_pos ((const int*)args.in[2])
#define norm_g ((const float*)args.in[3])
#define CS ((f32x2*)(ws + WS_CS))
#define RINVQ ((float*)(ws + WS_RINVQ))
#define RINVK ((float*)(ws + WS_RINVK))
#define MEMK ((bf16_t*)(ws + WS_MEMK))
#define MEMVT ((bf16_t*)(ws + WS_MEMVT))
#define MEMN ((bf16_t*)(ws + WS_MEMN))
#define KR ((bf16_t*)(ws + WS_KR))
#define LSE ((float*)(ws + WS_LSE))
#define WGU ((bf16_t*)(ws + WS_WGU))
#define WD ((bf16_t*)(ws + WS_WD))
#define WIN ((bf16_t*)(ws + WS_WIN))
#define WOUT ((bf16_t*)(ws + WS_WOUT))
#define WUQ ((bf16_t*)(ws + WS_WUQ))
#define WUKV ((bf16_t*)(ws + WS_WUKV))
#define WMKV ((bf16_t*)(ws + WS_WMKV))
#define HB ((bf16_t*)(ws + WS_HB))
#define CAT ((bf16_t*)(ws + WS_CAT))
#define OG ((bf16_t*)(ws + WS_AUX))
#define Z ((bf16_t*)(ws + WS_Z))
#define Y ((float*)(ws + WS_Z + ZO_Y))
#define QB ((bf16_t*)(ws + WS_Z + ZO_Q))
#define KN ((bf16_t*)(ws + WS_Z + ZO_KN))
#define VT ((bf16_t*)(ws + WS_Z + ZO_VT))

    for (int opi = args.lo; opi < args.hi; ++opi) {
        int lane; asm volatile("v_mbcnt_lo_u32_b32 %0, -1, 0\n\tv_mbcnt_hi_u32_b32 %0, -1, %0" : "=v"(lane));
        int bx = blockIdx.x; asm volatile("" : "+s"(bx));
        unsigned char* ws = args.ws; asm volatile("" : "+s"(ws));
        const int wave = wave_s, tid = wave * 64 + lane;
        const int gw = bx * NWAVES + wave, NGW = G * NWAVES;
#define l32 (lane & 31)
#define hl (lane >> 5)
        const unsigned op = D_OPS.v[opi];
        const int kind = op & 255, L = (op >> 8) & 255, f = (op >> 16) & 255, dosync = (op >> 24) & 1;
        switch (kind) {
        case K_P0: {
            for (int r = gw; r < S; r += NGW) row_op(in_x + (size_t)r * DM, xres + (size_t)r * DM, nullptr, nullptr, 0.f, norm_g, HB + (size_t)r * DM, lane);
            for (int idx = bx * NTHREADS + tid; idx < S * 16; idx += G * NTHREADS) {
                const int t = idx >> 4, i = idx & 15;
                const float ang = (float)in_pos[t] * INVF[i];
                const float kf = rintf(ang * 0.15915494309189535f);
                const float rr = (float)((double)ang - (double)kf * 6.283185307179586);
                CS[idx] = (f32x2){cosf(rr), sinf(rr)};
            }
        } break;
        case K_PREP: {
            for (int r = gw; r < 256; r += NGW) row_op(in_mem + (size_t)r * DM, nullptr, nullptr, nullptr, 0.f, norm_g + (size_t)(L * 7 + 6) * DM, MEMN + (size_t)r * DM, lane);
            LAS float* scr = (LAS float*)(lds + wave * 16384);
            int base = 0;
            for (int ff = 0; ff < 2; ++ff) {
                const float* wg = (const float*)args.in[4] + (size_t)(L * 2 + ff) * DM * FF;
                const float* wu = (const float*)args.in[5] + (size_t)(L * 2 + ff) * DM * FF;
                const float* wd = (const float*)args.in[6] + (size_t)(L * 2 + ff) * FF * DM;
                xpose_seg(wg, FF, DM, 0, FF, WGU + (size_t)ff * 5632 * DM, DM, 0, 1, nullptr, scr, base, gw, NGW, lane);
                xpose_seg(wu, FF, DM, 0, FF, WGU + (size_t)ff * 5632 * DM, DM, 128, 1, nullptr, scr, base, gw, NGW, lane);
                xpose_seg(wd, DM, FF, 0, DM, WD + (size_t)ff * DM * FF, FF, 0, 0, nullptr, scr, base, gw, NGW, lane);
            }
            xpose_seg((const float*)args.in[7] + (size_t)L * DM * 512, 512, DM, 0, 512, WMKV, DM, 0, 0, nullptr, scr, base, gw, NGW, lane);
            if (L == 0) {
                xpose_seg((const float*)args.in[8], 928, DM, 0, 928, WIN, DM, 0, 0, nullptr, scr, base, gw, NGW, lane);
                xpose_seg((const float*)args.in[11], 1152, 384, 0, 1152, WUQ, 384, 0, 0, (const float*)args.in[9], scr, base, gw, NGW, lane);
                xpose_seg((const float*)args.in[12], 1536, 256, 0, 1536, WUKV, 256, 0, 2, (const float*)args.in[10], scr, base, gw, NGW, lane);
                xpose_seg((const float*)args.in[13], DM, DM, 0, DM, WOUT, DM, 0, 0, nullptr, scr, base, gw, NGW, lane);
                for (int idx = bx * NTHREADS + tid; idx < (96 * 1024 + 128 * 384) / 8; idx += G * NTHREADS) {
                    unsigned z0 = 0u; asm volatile("" : "+v"(z0));
                    const u32x4 zz = {z0, z0, z0, z0};
                    if (idx < 96 * 1024 / 8) *(u32x4*)(WIN + (size_t)928 * DM + (size_t)idx * 8) = zz;
                    else *(u32x4*)(WUQ + (size_t)1152 * 384 + (size_t)(idx - 96 * 1024 / 8) * 8) = zz;
                }
            } else if (L == 1) {
                xpose_seg((const float*)args.in[14], 4864, DM, 0, 4864, WIN, DM, 0, 0, nullptr, scr, base, gw, NGW, lane);
                xpose_seg((const float*)args.in[15], DM, 768, 0, DM, WOUT, 768, 0, 0, nullptr, scr, base, gw, NGW, lane);
            } else if (L == 2) {
                const float* w = (const float*)args.in[16];
                xpose_seg(w, 1792, DM, 0, 768, WIN, DM, 0, 1, nullptr, scr, base, gw, NGW, lane);
                xpose_seg(w, 1792, DM, 768, 768, WIN, DM, 128, 1, nullptr, scr, base, gw, NGW, lane);
                xpose_seg(w, 1792, DM, 1536, 256, WIN, DM, 1536, 0, nullptr, scr, base, gw, NGW, lane);
                xpose_seg((const float*)args.in[21], DM, DM, 0, DM, WOUT, DM, 0, 0, nullptr, scr, base, gw, NGW, lane);
            } else {
                const float* w = (const float*)args.in[22];
                xpose_seg(w, 2560, DM, 0, 768, WIN, DM, 0, 0, nullptr, scr, base, gw, NGW, lane);
                xpose_seg(w, 2560, DM, 768, 768, WIN, DM, 768, 1, nullptr, scr, base, gw, NGW, lane);
                xpose_seg(w, 2560, DM, 1536, 768, WIN, DM, 768 + 128, 1, nullptr, scr, base, gw, NGW, lane);
                xpose_seg(w, 2560, DM, 2304, 256, WIN, DM, 2304, 0, nullptr, scr, base, gw, NGW, lane);
                xpose_seg((const float*)args.in[24], DM, DM, 0, DM, WOUT, DM, 0, 0, nullptr, scr, base, gw, NGW, lane);
            }
        } break;
        case K_MEMKV: {
            pg8::Gemm g{MEMN, WMKV, 256, 512, DM, DM, DM}; pg8::StaticOrder so; so.init(256, 512, G, bx);
            pg8::EpiMemKV E{MEMK, MEMVT};
            pg8::gemm_phase<pg8::EpiMemKV>(lds, g, so, E, tid);
        } break;
        case K_GU: case K_INPROJ: case K_UPK: {
            pg8::Gemm g; pg8::EpiPair E; int c = bx;
            if (kind == K_GU) { g = pg8::Gemm{HB, WGU + (size_t)f * 5632 * DM, S, 5632, DM, DM, DM}; E = pg8::EpiPair{Z, FF, 0, 22, 0, nullptr}; }
            else if (kind == K_UPK) { g = pg8::Gemm{Z + 384, WUKV, S, 768, 256, DM, 256}; E = pg8::EpiPair{KN, 768, 0, 0, 0, RINVK}; c = (bx + 192) % G; }
            else {
                const int N = (L == 0) ? 1024 : (L == 1 ? 4864 : (L == 2 ? 1792 : 2560));
                const int ldz = (L == 0) ? 1024 : (L == 1 ? 4864 : (L == 2 ? 1024 : 1792));
                const int plo = (L == 3) ? 3 : 0, phi = (L == 2) ? 6 : (L == 3 ? 9 : 0), pop = (L == 2) ? 1 : 2;
                g = pg8::Gemm{HB, WIN, S, N, DM, DM, DM}; E = pg8::EpiPair{Z, ldz, plo, phi, pop, nullptr};
            }
            pg8::StaticOrder so; so.init(g.M, g.N, G, c);
            pg8::gemm_phase<pg8::EpiPair>(lds, g, so, E, tid);
        } break;
        case K_DOWN: case K_OUTPROJ: {
            pg8::Gemm g;
            if (kind == K_DOWN) g = pg8::Gemm{Z, WD + (size_t)f * DM * FF, S, DM, FF, FF, FF};
            else { const int kk = (L == 1) ? 768 : 1024; g = pg8::Gemm{CAT, WOUT, S, DM, kk, kk, kk}; }
            pg8::StaticOrder so; so.init(g.M, g.N, G, bx);
            pg8::EpiF32 E{Y, DM};
            pg8::gemm_phase<pg8::EpiF32>(lds, g, so, E, tid);
        } break;
        case K_ROW: {
            const float* gl = norm_g + (size_t)L * 7 * DM;
            const float* gA = gl + (f == 0 ? 1 : (f == 1 ? 3 : 5)) * DM;
            const float* gB = (f == 0) ? gl + 2 * DM : (f == 1 ? gl + 4 * DM : (L < 3 ? gl + 7 * DM : nullptr));
            const float sc = (f == 1) ? 1.f : 0.5f;
            for (int r = gw; r < S; r += NGW) row_op(xres + (size_t)r * DM, xres + (size_t)r * DM, Y + (size_t)r * DM, gA, sc, gB, HB + (size_t)r * DM, lane);
        } break;
        case K_MLASTAT: {
            for (int r = gw; r < S; r += NGW) {
                const u32x4 a = *(const u32x4*)(Z + (size_t)r * DM + 8 * lane);
                const u32x4 b = *(const u32x4*)(Z + (size_t)r * DM + 512 + 8 * lane);
                float av[8], bv[8];
                av[0] = bflo(a.x); av[1] = bfhi(a.x); av[2] = bflo(a.y); av[3] = bfhi(a.y); av[4] = bflo(a.z); av[5] = bfhi(a.z); av[6] = bflo(a.w); av[7] = bfhi(a.w);
                bv[0] = bflo(b.x); bv[1] = bfhi(b.x); bv[2] = bflo(b.y); bv[3] = bfhi(b.y); bv[4] = bflo(b.z); bv[5] = bfhi(b.z); bv[6] = bflo(b.w); bv[7] = bfhi(b.w);
                float sa = 0.f, sb = 0.f;
#pragma unroll
                for (int e = 0; e < 8; ++e) { sa += av[e] * av[e]; sb += bv[e] * bv[e]; }
                const float ssq = wave_sum(lane < 48 ? sa : 0.f);
                const float ssk = wave_sum((lane >= 48 ? sa : 0.f) + (lane < 16 ? sb : 0.f));
                if (lane == 0) { RINVQ[r] = 1.f / sqrtf(ssq * (1.f / 384.f) + EPS); RINVK[r] = 1.f / sqrtf(ssk * (1.f / 256.f) + EPS); }
                float pv[8];
#pragma unroll
                for (int e = 0; e < 8; ++e) pv[e] = __shfl_xor(bv[e], 2);
                if (lane >= 16 && lane < 20) {
                    const int i0 = 8 * ((lane - 16) & 1);
                    const float sgn = (lane < 18) ? -1.f : 1.f;
                    float ov[8];
#pragma unroll
                    for (int e = 0; e < 8; ++e) { const f32x2 c2 = CS[(size_t)r * 16 + i0 + e]; ov[e] = bv[e] * c2[0] + sgn * pv[e] * c2[1]; }
                    u32x4 w; w.x = pk2(ov[0], ov[1]); w.y = pk2(ov[2], ov[3]); w.z = pk2(ov[4], ov[5]); w.w = pk2(ov[6], ov[7]);
                    *(u32x4*)(KR + (size_t)r * 32 + 8 * (lane - 16)) = w;
                }
            }
        } break;
        case K_MEMATT: {
            const int ldq = (L == 0) ? 1024 : (L == 1 ? 4864 : (L == 2 ? 1024 : 1792));
            const int qoff = (L == 0) ? 672 : (L == 1 ? 4608 : (L == 2 ? 768 : 1536));
            const int ldc = (L == 1) ? 768 : 1024, coff = (L == 1) ? 512 : 768;
            constexpr int KSTR = 144, VSTR = 520, KB = 256 * KSTR;
            const float cscale = 0.125f * LOG2E;
            for (int u = bx; u < 256; u += G) {
                const int h = u & 3, rb = u >> 2;
#pragma unroll
                for (int c4 = 0; c4 < 4; ++c4) {
                    const int chunk = tid + 512 * c4;
                    { const int key = chunk >> 3, c = chunk & 7; const u32x4 v = *(const u32x4*)(MEMK + (size_t)key * 256 + h * 64 + 8 * c); *(LAS u32x4*)(lds + key * KSTR + 16 * c) = v; }
                    { const int d = chunk >> 5, c = chunk & 31; const u32x4 v = *(const u32x4*)(MEMVT + (size_t)(h * 64 + d) * 256 + 8 * c);
                      LAS u32x2* dp = (LAS u32x2*)(lds + KB + d * VSTR + 16 * c); dp[0] = (u32x2){v.x, v.y}; dp[1] = (u32x2){v.z, v.w}; }
                }
                __syncthreads();
                const int q0 = rb * 256 + wave * 32;
                bf16x8 qf[4];
#pragma unroll
                for (int s = 0; s < 4; ++s) qf[s] = *(const bf16x8*)(Z + (size_t)(q0 + l32) * ldq + qoff + h * 64 + 16 * s + 8 * hl);
                f32x16 o[2];
#pragma unroll
                for (int i = 0; i < 16; ++i) { o[0][i] = 0.f; o[1][i] = 0.f; }
                float m = -INFINITY, l = 0.f;
#pragma unroll 1
                for (int t = 0; t < 4; ++t)
                    attn_tile<4>(lds + t * 64 * KSTR, KSTR, lds + KB + t * 128, VSTR, qf, o, m, l, l32, hl, [&](float v, int) { return v * cscale; });
                attn_store(CAT + (size_t)(q0 + l32) * ldc + coff + h * 64, o, 1.f / l, hl);
                __syncthreads();
            }
        } break;
        case K_UPQ: {
            pg8::Gemm g{Z, WUQ, S, 1280, 384, DM, 384}; pg8::StaticOrder so; so.init(S, 1280, G, bx);
            pg8::EpiQ E{QB, 1280, RINVQ, (const f32x4*)CS};
            pg8::gemm_phase<pg8::EpiQ>(lds, g, so, E, tid);
        } break;
        case K_UPV: {
            pg8::Gemm g{WUKV + (size_t)768 * 256, Z + 384, 768, S, 256, 256, DM}; pg8::StaticOrder so; so.init(768, S, G, bx);
            pg8::EpiColScale E{VT, S, RINVK};
            pg8::gemm_phase<pg8::EpiColScale>(lds, g, so, E, tid);
        } break;
        case K_MLAATT: {
            constexpr int KSTR = 208, VSTR = 136, KBYTES = 64 * KSTR, BUF = KBYTES + 64 * VSTR;
            const float cscale = 0.10206207261596577f * LOG2E;
            for (int i = 0;; ++i) {
                int u;
                if (G == 256) { if (i >= 3) break; u = 96 * (bx & 7) + 32 * i + (bx >> 3); } else { u = bx + i * G; if (u >= 768) break; }
                const int h = u >> 6, qb = u & 63;
                const int q0 = qb * 256 + wave * 32;
                bf16x8 qf[6];
#pragma unroll
                for (int s = 0; s < 6; ++s) qf[s] = *(const bf16x8*)(QB + (size_t)(q0 + l32) * 1280 + h * 96 + 16 * s + 8 * hl);
                f32x16 o[2];
#pragma unroll
                for (int k = 0; k < 16; ++k) { o[0][k] = 0.f; o[1][k] = 0.f; }
                float m = -INFINITY, l = 0.f;
                const int kkey = tid >> 3, kc = tid & 7, rkey = (tid >> 2) & 63, rc = tid & 3;
                const bf16_t* pkn = KN + (size_t)kkey * 768 + h * 64 + 8 * kc;
                const bf16_t* pkr = KR + (size_t)rkey * 32 + 8 * rc;
                const bf16_t* pvt = VT + (size_t)(h * 64 + kkey) * S + 8 * kc;
                const int dkn = kkey * KSTR + 16 * kc, dkr = rkey * KSTR + 128 + 16 * rc, dvt = KBYTES + kkey * VSTR + 16 * kc;
                u32x4 rkn = *(const u32x4*)pkn, rkr = *(const u32x4*)pkr, rvt = *(const u32x4*)pvt;
                { *(LAS u32x4*)(lds + dkn) = rkn; if (tid < 256) *(LAS u32x4*)(lds + dkr) = rkr;
                  LAS u32x2* dp = (LAS u32x2*)(lds + dvt); dp[0] = (u32x2){rvt.x, rvt.y}; dp[1] = (u32x2){rvt.z, rvt.w}; }
                __syncthreads();
#pragma unroll 1
                for (int t = 0; t < 256; ++t) {
                    const bool more = (t + 1 < 256);
                    if (more) { const size_t k1 = (size_t)(t + 1) * 64; rkn = *(const u32x4*)(pkn + k1 * 768); rkr = *(const u32x4*)(pkr + k1 * 32); rvt = *(const u32x4*)(pvt + k1); }
                    const LAS unsigned char* bufp = lds + (t & 1) * BUF;
                    attn_tile<6>(bufp, KSTR, bufp + KBYTES, VSTR, qf, o, m, l, l32, hl, [&](float v, int) { return v * cscale; });
                    if (more) { LAS unsigned char* nb = lds + ((t + 1) & 1) * BUF;
                        *(LAS u32x4*)(nb + dkn) = rkn; if (tid < 256) *(LAS u32x4*)(nb + dkr) = rkr;
                        LAS u32x2* dp = (LAS u32x2*)(nb + dvt); dp[0] = (u32x2){rvt.x, rvt.y}; dp[1] = (u32x2){rvt.z, rvt.w}; }
                    __syncthreads();
                }
                attn_store(CAT + (size_t)(q0 + l32) * 1024 + h * 64, o, 1.f / l, hl);
            }
        } break;
        case K_DILATT: {
            constexpr int KSTR = 144, VSTR = 776, VB = 384 * KSTR;
            const float cscale = 0.125f * LOG2E;
            for (int u = bx; u < 1536; u += G) {
                const int g = u >> 9, rem = u & 511, h = rem >> 6, w = rem & 63;
                const int lgd = 2 * g, dl = 1 << lgd, r = w & (dl - 1), q4 = w >> lgd, sub_len = S >> lgd;
                const int base_l = 256 * q4 - 64;
                const bf16_t* zk = Z + (size_t)(g * 3 + 1) * 512 + h * 64;
                const bf16_t* zv = Z + (size_t)(g * 3 + 2) * 512 + h * 64;
#pragma unroll 2
                for (int c6 = 0; c6 < 6; ++c6) {
                    const int chunk = tid + 512 * c6, key = chunk >> 3, c = chunk & 7, lk = base_l + key;
                    const bool ok = (lk >= 0 && lk < sub_len);
                    const size_t t = (size_t)(ok ? lk : 0) * dl + r;
                    u32x4 kv4 = *(const u32x4*)(zk + t * 4864 + 8 * c), vv4 = *(const u32x4*)(zv + t * 4864 + 8 * c);
                    if (!ok) { kv4 = (u32x4){0u, 0u, 0u, 0u}; vv4 = kv4; }
                    *(LAS u32x4*)(lds + key * KSTR + 16 * c) = kv4;
                    LAS bf16_t* vp = (LAS bf16_t*)(lds + VB + (8 * c) * VSTR + key * 2);
                    vp[0 * (VSTR / 2)] = (bf16_t)(vv4.x & 0xffffu); vp[1 * (VSTR / 2)] = (bf16_t)(vv4.x >> 16);
                    vp[2 * (VSTR / 2)] = (bf16_t)(vv4.y & 0xffffu); vp[3 * (VSTR / 2)] = (bf16_t)(vv4.y >> 16);
                    vp[4 * (VSTR / 2)] = (bf16_t)(vv4.z & 0xffffu); vp[5 * (VSTR / 2)] = (bf16_t)(vv4.z >> 16);
                    vp[6 * (VSTR / 2)] = (bf16_t)(vv4.w & 0xffffu); vp[7 * (VSTR / 2)] = (bf16_t)(vv4.w >> 16);
                }
                __syncthreads();
                const int b = wave >> 1, lq = 256 * q4 + 32 * wave + l32;
                const size_t tq = (size_t)lq * dl + r;
                bf16x8 qf[4];
#pragma unroll
                for (int s = 0; s < 4; ++s) qf[s] = *(const bf16x8*)(Z + tq * 4864 + (size_t)(g * 3) * 512 + h * 64 + 16 * s + 8 * hl);
                f32x16 o[2];
#pragma unroll
                for (int k = 0; k < 16; ++k) { o[0][k] = 0.f; o[1][k] = 0.f; }
                float m = -INFINITY, l = 0.f;
                const float slope2 = fexp2(-(float)(8 * g + h + 1) * (1.f / 3.f)) * (float)dl * LOG2E;
#pragma unroll 1
                for (int tt = 0; tt < 3; ++tt) {
                    const int j = b + tt, lk0 = base_l + 64 * j;
                    attn_tile<4>(lds + j * 64 * KSTR, KSTR, lds + VB + j * 128, VSTR, qf, o, m, l, l32, hl, [&](float v, int key) {
                        const int lk = lk0 + key, rel = lk - lq, a = rel < 0 ? -rel : rel;
                        const bool ok = (a <= 64) && (lk >= 0) && (lk < sub_len);
                        return ok ? v * cscale - slope2 * (float)a : -INFINITY; });
                }
                attn_store(OG + ((size_t)g * S + tq) * 512 + h * 64, o, 1.f / l, hl);
                if (hl == 0) LSE[((size_t)g * S + tq) * 8 + h] = m + __builtin_amdgcn_logf(l);
                __syncthreads();
            }
        } break;
        case K_MERGE: {
            for (int idx = bx * NTHREADS + tid; idx < S * 64; idx += G * NTHREADS) {
                const int t = idx >> 6, h = (idx >> 3) & 7, c = idx & 7;
                const float l0 = LSE[((size_t)0 * S + t) * 8 + h], l1 = LSE[((size_t)1 * S + t) * 8 + h], l2 = LSE[((size_t)2 * S + t) * 8 + h];
                const float mx = fmaxf(l0, fmaxf(l1, l2));
                float w0 = fexp2(l0 - mx), w1 = fexp2(l1 - mx), w2 = fexp2(l2 - mx);
                const float inv = 1.f / (w0 + w1 + w2); w0 *= inv; w1 *= inv; w2 *= inv;
                const u32x4 a0 = *(const u32x4*)(OG + ((size_t)0 * S + t) * 512 + h * 64 + 8 * c);
                const u32x4 a1 = *(const u32x4*)(OG + ((size_t)1 * S + t) * 512 + h * 64 + 8 * c);
                const u32x4 a2 = *(const u32x4*)(OG + ((size_t)2 * S + t) * 512 + h * 64 + 8 * c);
                u32x4 w;
                w.x = pk2(w0 * bflo(a0.x) + w1 * bflo(a1.x) + w2 * bflo(a2.x), w0 * bfhi(a0.x) + w1 * bfhi(a1.x) + w2 * bfhi(a2.x));
                w.y = pk2(w0 * bflo(a0.y) + w1 * bflo(a1.y) + w2 * bflo(a2.y), w0 * bfhi(a0.y) + w1 * bfhi(a1.y) + w2 * bfhi(a2.y));
                w.z = pk2(w0 * bflo(a0.z) + w1 * bflo(a1.z) + w2 * bflo(a2.z), w0 * bfhi(a0.z) + w1 * bfhi(a1.z) + w2 * bfhi(a2.z));
                w.w = pk2(w0 * bflo(a0.w) + w1 * bflo(a1.w) + w2 * bflo(a2.w), w0 * bfhi(a0.w) + w1 * bfhi(a1.w) + w2 * bfhi(a2.w));
                *(u32x4*)(CAT + (size_t)t * 768 + h * 64 + 8 * c) = w;
            }
        } break;
        case K_CONV: {
            const float* cw = (const float*)args.in[17]; const float* cb = (const float*)args.in[18];
            const float* lng = (const float*)args.in[19]; const float* lnb = (const float*)args.in[20];
            constexpr int RSTR = 1536, RED = 73728;
            LAS float* red = (LAS float*)(lds + RED);
            for (int u = bx; u < 1024; u += G) {
                const int t0 = 16 * u;
                int tl = tid; asm volatile("" : "+v"(tl));
                for (int chunk = tl; chunk < 46 * 96; chunk += NTHREADS) {
                    const int rr = chunk / 96, c = chunk - rr * 96, t = t0 - 15 + rr;
                    u32x4 v = {0u, 0u, 0u, 0u};
                    if (t >= 0 && t < S) v = *(const u32x4*)(Z + (size_t)t * 1024 + 8 * c);
                    *(LAS u32x4*)(lds + rr * RSTR + 16 * c) = v;
                }
                __syncthreads();
                int cgx = tid & 255; asm volatile("" : "+v"(cgx));
                const int th = wave >> 2;
                float v[3][8], s1[8], s2[8];
#pragma unroll
                for (int k = 0; k < 3; ++k) {
                    const int c = cgx + 256 * k;
                    float wj[31];
                    const float* cwp = cw + c; asm volatile("" : "+v"(cwp));
#pragma unroll
                    for (int j = 0; j < 31; ++j) wj[j] = cwp[j * 768];
                    const float bias = cb[c];
                    float acc[8];
#pragma unroll
                    for (int o = 0; o < 8; ++o) acc[o] = bias;
#pragma unroll
                    for (int i = 0; i < 38; ++i) {
                        const float xv = bf2f(*(const LAS bf16_t*)(lds + (th * 8 + i) * RSTR + 2 * c));
#pragma unroll
                        for (int o = 0; o < 8; ++o) { if (i - o >= 0 && i - o < 31) acc[o] += wj[i - o] * xv; }
                        if ((i & 7) == 7) asm volatile("" ::: "memory");
                    }
#pragma unroll
                    for (int o = 0; o < 8; ++o) v[k][o] = acc[o];
                    asm volatile("" ::: "memory");
                }
#pragma unroll
                for (int o = 0; o < 8; ++o) { s1[o] = (v[0][o] + v[1][o]) + v[2][o]; s2[o] = (v[0][o] * v[0][o] + v[1][o] * v[1][o]) + v[2][o] * v[2][o]; }
#pragma unroll
                for (int o = 0; o < 8; ++o) { s1[o] = wave_sum(s1[o]); s2[o] = wave_sum(s2[o]); }
                if (lane == 0) {
#pragma unroll
                    for (int o = 0; o < 8; ++o) { red[wave * 16 + o] = s1[o]; red[wave * 16 + 8 + o] = s2[o]; }
                }
                __syncthreads();
#pragma unroll
                for (int o = 0; o < 8; ++o) {
                    const float a = (red[(th * 4 + 0) * 16 + o] + red[(th * 4 + 1) * 16 + o]) + (red[(th * 4 + 2) * 16 + o] + red[(th * 4 + 3) * 16 + o]);
                    const float q = (red[(th * 4 + 0) * 16 + 8 + o] + red[(th * 4 + 1) * 16 + 8 + o]) + (red[(th * 4 + 2) * 16 + 8 + o] + red[(th * 4 + 3) * 16 + 8 + o]);
                    const float mean = a * (1.f / 768.f);
                    const float var = fmaxf(q * (1.f / 768.f) - mean * mean, 0.f);
                    s1[o] = mean; s2[o] = 1.f / sqrtf(var + EPS);
                }
#pragma unroll
                for (int k = 0; k < 3; ++k) {
                    const int c = cgx + 256 * k;
                    const float gg = lng[c], bb = lnb[c];
#pragma unroll
                    for (int o = 0; o < 8; ++o) {
                        const float yv = (v[k][o] - s1[o]) * s2[o] * gg + bb;
                        CAT[(size_t)(t0 + th * 8 + o) * 1024 + c] = (bf16_t)(pk2(silu_f(yv), 0.f) & 0xffffu);
                    }
                }
                __syncthreads();
            }
        } break;
        case K_SCONV: {
            const float* dw = (const float*)args.in[23];
            for (int idx = bx * NTHREADS + tid; idx < S * 96; idx += G * NTHREADS) {
                const int t = idx / 96, c = idx - t * 96;
                const bf16_t* zr = Z + (size_t)t * 1792;
                const u32x4 bg = *(const u32x4*)(zr + 8 * c);
                const u32x4 v0 = *(const u32x4*)(zr + 768 + 8 * c);
                u32x4 vm = {0u, 0u, 0u, 0u}, vp = {0u, 0u, 0u, 0u};
                if (t > 0) vm = *(const u32x4*)(zr - 1792 + 768 + 8 * c);
                if (t < S - 1) vp = *(const u32x4*)(zr + 1792 + 768 + 8 * c);
                const f32x4 wa0 = *(const f32x4*)(dw + 8 * c), wa1 = *(const f32x4*)(dw + 8 * c + 4);
                const f32x4 wb0 = *(const f32x4*)(dw + 768 + 8 * c), wb1 = *(const f32x4*)(dw + 768 + 8 * c + 4);
                const f32x4 wc0 = *(const f32x4*)(dw + 1536 + 8 * c), wc1 = *(const f32x4*)(dw + 1536 + 8 * c + 4);
                u32x4 w;
                w.x = pk2(bflo(bg.x) * (wa0[0] * bflo(vm.x) + wb0[0] * bflo(v0.x) + wc0[0] * bflo(vp.x)), bfhi(bg.x) * (wa0[1] * bfhi(vm.x) + wb0[1] * bfhi(v0.x) + wc0[1] * bfhi(vp.x)));
                w.y = pk2(bflo(bg.y) * (wa0[2] * bflo(vm.y) + wb0[2] * bflo(v0.y) + wc0[2] * bflo(vp.y)), bfhi(bg.y) * (wa0[3] * bfhi(vm.y) + wb0[3] * bfhi(v0.y) + wc0[3] * bfhi(vp.y)));
                w.z = pk2(bflo(bg.z) * (wa1[0] * bflo(vm.z) + wb1[0] * bflo(v0.z) + wc1[0] * bflo(vp.z)), bfhi(bg.z) * (wa1[1] * bfhi(vm.z) + wb1[1] * bfhi(v0.z) + wc1[1] * bfhi(vp.z)));
                w.w = pk2(bflo(bg.w) * (wa1[2] * bflo(vm.w) + wb1[2] * bflo(v0.w) + wc1[2] * bflo(vp.w)), bfhi(bg.w) * (wa1[3] * bfhi(vm.w) + wb1[3] * bfhi(v0.w) + wc1[3] * bfhi(vp.w)));
                *(u32x4*)(CAT + (size_t)t * 1024 + 8 * c) = w;
            }
        } break;
        default: break;
        }
        __syncthreads();
        if (dosync && opi + 1 < args.hi) grid.sync();
    }
}

extern "C" void kernel_launch(void* const* d_in, const int* in_sizes, int n_in, void* d_out, int out_size, void* d_ws, size_t ws_size, hipStream_t stream) {
    static int grid = 0;
    if (grid == 0) {
        if (n_in != 25 || out_size != S * DM || ws_size < WS_END) { fprintf(stderr, "kernel_launch: unexpected shapes (n_in %d, out %d, ws %zu < %zu)\n", n_in, out_size, ws_size, (size_t)WS_END); grid = -1; return; }
        int dev = 0, cus = 0, per_cu = 0;
        if (hipGetDevice(&dev) != hipSuccess || hipDeviceGetAttribute(&cus, hipDeviceAttributeMultiprocessorCount, dev) != hipSuccess) { grid = -1; return; }
        if (hipFuncSetAttribute((const void*)fwd_megakernel, hipFuncAttributeMaxDynamicSharedMemorySize, LDS_BYTES) != hipSuccess) { fprintf(stderr, "kernel_launch: hipFuncSetAttribute failed\n"); grid = -1; return; }
        if (hipOccupancyMaxActiveBlocksPerMultiprocessor(&per_cu, (const void*)fwd_megakernel, NTHREADS, LDS_BYTES) != hipSuccess || per_cu < 1) { fprintf(stderr, "kernel_launch: occupancy query says %d\n", per_cu); per_cu = 1; }
        (void)hipGetLastError();
        grid = cus * per_cu;
    }
    if (grid < 0) return;
    Args a{};
    for (int i = 0; i < 25; ++i) a.in[i] = d_in[i];
    a.out = (float*)d_out; a.ws = (unsigned char*)d_ws;
#if MK_MULTI_LAUNCH
    int lo = 0;
    for (int i = 0; i < H_OPS.n; ++i) {
        if ((H_OPS.v[i] >> 24) & 1u) { a.lo = lo; a.hi = i + 1; hipLaunchKernelGGL(fwd_megakernel, dim3(grid), dim3(NTHREADS), LDS_BYTES, stream, a); lo = i + 1; }
    }
#else
    a.lo = 0; a.hi = H_OPS.n;
    void* kargs[] = {&a};
    hipError_t e = hipLaunchCooperativeKernel((const void*)fwd_megakernel, dim3(grid), dim3(NTHREADS), kargs, LDS_BYTES, stream);
    if (e != hipSuccess) fprintf(stderr, "cooperative launch failed: %s (grid %d)\n", hipGetErrorString(e), grid);
#endif
}
```

```cpp
#include <hip/hip_runtime.h>
#include <hip/hip_cooperative_groups.h>
#include <cstdio>
#include <cstdint>
namespace cg = cooperative_groups;

#ifndef MK_MULTI_LAUNCH
#define MK_MULTI_LAUNCH 0
#endif

#define LAS __attribute__((address_space(3)))
typedef unsigned short bf16_t;
typedef short bf16x8 __attribute__((ext_vector_type(8)));
typedef short s16x4 __attribute__((ext_vector_type(4)));
typedef float f32x2 __attribute__((ext_vector_type(2)));
typedef float f32x4 __attribute__((ext_vector_type(4)));
typedef float f32x16 __attribute__((ext_vector_type(16)));
typedef unsigned u32x2 __attribute__((ext_vector_type(2)));
typedef unsigned u32x4 __attribute__((ext_vector_type(4)));
typedef __bf16 bf2_t __attribute__((ext_vector_type(2)));
#define DI __device__ __forceinline__

constexpr int S = 16384, DM = 1024, FF = 2816;
constexpr float EPS = 1e-6f;
constexpr float LOG2E = 1.4426950408889634f;
constexpr int NWAVES = 8, NTHREADS = 512;
constexpr int LDS_BYTES = 147456;

constexpr size_t MiB = 1ull << 20;
constexpr size_t WS_CS = 0;
constexpr size_t WS_RINVQ = 2 * MiB;
constexpr size_t WS_RINVK = 2 * MiB + 65536;
constexpr size_t WS_MEMK = 2 * MiB + 131072;
constexpr size_t WS_MEMVT = 2 * MiB + 262144;
constexpr size_t WS_MEMN = 2 * MiB + 524288;
constexpr size_t WS_KR = 3 * MiB;
constexpr size_t WS_LSE = 4 * MiB;
constexpr size_t WS_BAR = 5 * MiB + 512 * 1024;
constexpr size_t WS_WGU = 6 * MiB;
constexpr size_t WS_WD = 28 * MiB;
constexpr size_t WS_WIN = 39 * MiB;
constexpr size_t WS_WOUT = 49 * MiB;
constexpr size_t WS_WUQ = 51 * MiB;
constexpr size_t WS_WUKV = 52 * MiB;
constexpr size_t WS_WMKV = 53 * MiB;
constexpr size_t WS_HB = 54 * MiB;
constexpr size_t WS_CAT = 86 * MiB;
constexpr size_t WS_AUX = 118 * MiB;
constexpr size_t WS_Z = 166 * MiB;
constexpr size_t WS_END = 318 * MiB;
constexpr size_t ZO_Y = 88 * MiB, ZO_Q = 32 * MiB, ZO_KN = 72 * MiB, ZO_VT = 96 * MiB;

enum { K_P0 = 0, K_PREP, K_MEMKV, K_GU, K_DOWN, K_ROW, K_INPROJ, K_MLASTAT, K_MEMATT, K_UPQ, K_UPK, K_UPV, K_MLAATT, K_DILATT, K_MERGE, K_CONV, K_SCONV, K_OUTPROJ };
struct OpTable { unsigned v[96]; int n; };
constexpr OpTable make_ops() {
    OpTable t{}; int n = 0;
    auto add = [&](int k, int L, int f, int sync) { t.v[n++] = (unsigned)k | ((unsigned)L << 8) | ((unsigned)f << 16) | ((unsigned)sync << 24); };
    add(K_P0, 0, 0, 0); add(K_PREP, 0, 0, 1);
    for (int L = 0; L < 4; ++L) {
        add(K_MEMKV, L, 0, 0); add(K_GU, L, 0, 1); add(K_DOWN, L, 0, 1); add(K_ROW, L, 0, 1);
        add(K_INPROJ, L, 0, 1);
        if (L == 0) { add(K_MLASTAT, L, 0, 0); add(K_MEMATT, L, 0, 1); add(K_UPQ, L, 0, 0); add(K_UPK, L, 0, 0); add(K_UPV, L, 0, 1); add(K_MLAATT, L, 0, 1); }
        if (L == 1) { add(K_DILATT, L, 0, 0); add(K_MEMATT, L, 0, 1); add(K_MERGE, L, 0, 1); }
        if (L == 2) { add(K_CONV, L, 0, 0); add(K_MEMATT, L, 0, 1); }
        if (L == 3) { add(K_SCONV, L, 0, 0); add(K_MEMATT, L, 0, 1); }
        add(K_OUTPROJ, L, 0, 1); add(K_ROW, L, 1, 1);
        add(K_GU, L, 1, 1); add(K_DOWN, L, 1, 1);
        if (L < 3) { add(K_ROW, L, 2, 0); add(K_PREP, L + 1, 0, 1); } else add(K_ROW, L, 2, 1);
    }
    t.n = n; return t;
}
constexpr OpTable H_OPS = make_ops();
__constant__ OpTable D_OPS = make_ops();

__constant__ float INVF[16] = {1.000000000e+00f, 5.623413324e-01f, 3.162277639e-01f, 1.778279394e-01f, 1.000000015e-01f, 5.623413250e-02f, 3.162277490e-02f, 1.778279431e-02f,
                               9.999999776e-03f, 5.623413250e-03f, 3.162277630e-03f, 1.778279431e-03f, 1.000000047e-03f, 5.623413017e-04f, 3.162277571e-04f, 1.778279402e-04f};

DI unsigned pk2(float lo, float hi) { f32x2 v = {lo, hi}; bf2_t r = __builtin_convertvector(v, bf2_t); return __builtin_bit_cast(unsigned, r); }
DI float bf2f(unsigned short b) { return __uint_as_float(((unsigned)b) << 16); }
DI float bflo(unsigned w) { return __uint_as_float(w << 16); }
DI float bfhi(unsigned w) { return __uint_as_float(w & 0xffff0000u); }
DI float wave_sum(float v) {
#pragma unroll
    for (int o = 1; o < 64; o <<= 1) v += __shfl_xor(v, o);
    return v;
}
DI float fexp2(float x) { return __builtin_amdgcn_exp2f(x); }
DI float frcp(float x) { return __builtin_amdgcn_rcpf(x); }
DI float silu_f(float g) { return g * frcp(1.f + fexp2(-g * LOG2E)); }
DI float sigmoid_f(float g) { return frcp(1.f + fexp2(-g * LOG2E)); }

namespace pg8 {
constexpr int BM = 256, BK = 64, HALF = 128, HTB = HALF * BK * 2, STAGE_BYTES = 8 * HTB, NXCD = 8, WGM = 8;
DI int lds_byte(int r, int c) { const int st = (r >> 4) * 2 + (c >> 5), rr = r & 15, cc = c & 31, ob = rr * 64 + cc * 2; return st * 1024 + (ob ^ (((ob >> 9) & 1) << 5)); }
DI void stage_rc(int b, int& R, int& C) { const int st = b / 1024, sb = b % 1024, swz = sb ^ (((sb >> 9) & 1) << 5); R = (st >> 1) * 16 + swz / 64; C = (st & 1) * 32 + (swz % 64) / 2; }
DI int perm32(int rho) { const int n = rho >> 4, i = rho & 15; return 8 * (i >> 2) + 4 * n + (i & 3); }

struct Unit { int pm, pn; };
struct Gemm { const bf16_t* A; const bf16_t* Bt; int M, N, K, lda, ldb; };

struct StaticOrder {
    int nM, nN, nwg, G, c;
    DI void init(int M, int N, int G_, int c_) { nM = M / BM; nN = N / BM; nwg = nM * nN; G = G_; c = c_; }
    DI bool next(int i, Unit& u) const {
        const long L = (long)i * G + c; if (L >= nwg) return false;
        int wgid = (int)L; { const int q = nwg / NXCD, r = nwg % NXCD, xcd = wgid % NXCD, off = wgid / NXCD; wgid = (xcd < r ? xcd * (q + 1) : r * (q + 1) + (xcd - r) * q) + off; }
        const int nig = WGM * nN, gid = wgid / nig, fm = gid * WGM, gsz = (nM - fm) < WGM ? (nM - fm) : WGM;
        u.pm = fm + ((wgid % nig) % gsz); u.pn = (wgid % nig) / gsz; return true;
    }
};


struct EpiF32 {
    static constexpr bool PERM = false;
    float* O; int ldc;
    DI void operator()(const f32x4 (&acc)[2][2][4][2], const Unit& u, int wr, int wc, int fr, int fq) const {
        const int row0 = u.pm * BM + wr * 64 + fr, col0 = u.pn * BM + wc * 32 + 4 * fq;
#pragma unroll
        for (int ai = 0; ai < 2; ++ai)
#pragma unroll
            for (int m = 0; m < 4; ++m) { float* rowp = O + (size_t)(row0 + ai * HALF + m * 16) * ldc + col0;
#pragma unroll
                for (int bj = 0; bj < 2; ++bj)
#pragma unroll
                    for (int n = 0; n < 2; ++n) *(f32x4*)(rowp + bj * HALF + n * 16) = acc[ai][bj][m][n];
                asm volatile("" ::: "memory"); }
    }
};

struct EpiPair {
    static constexpr bool PERM = true;
    bf16_t* O; int ldc, lo, hi, op; const float* rowscale;
    DI void operator()(const f32x4 (&acc)[2][2][4][2], const Unit& u, int wr, int wc, int fr, int fq) const {
        const int row0 = u.pm * BM + wr * 64 + fr;
        const bool paired = (u.pn >= lo && u.pn < hi);
        const int colbase = u.pn < lo ? 256 * u.pn : (u.pn < hi ? 256 * lo + 128 * (u.pn - lo) : 256 * lo + 128 * (hi - lo) + 256 * (u.pn - hi));
        const int col0 = colbase + wc * 32 + 8 * fq;
#pragma unroll
        for (int ai = 0; ai < 2; ++ai)
#pragma unroll
            for (int m = 0; m < 4; ++m) {
                const int r = row0 + ai * HALF + m * 16;
                bf16_t* rowp = O + (size_t)r * ldc + col0;
                if (paired) {
                    float a[8], b[8], v[8];
#pragma unroll
                    for (int e = 0; e < 4; ++e) { a[e] = acc[ai][0][m][0][e]; a[4 + e] = acc[ai][0][m][1][e]; b[e] = acc[ai][1][m][0][e]; b[4 + e] = acc[ai][1][m][1][e]; }
                    if (op == 0) {
#pragma unroll
                        for (int e = 0; e < 8; ++e) v[e] = silu_f(a[e]) * b[e];
                    } else if (op == 1) {
#pragma unroll
                        for (int e = 0; e < 8; ++e) v[e] = a[e] * sigmoid_f(b[e]);
                    } else {
#pragma unroll
                        for (int e = 0; e < 8; ++e) v[e] = a[e] * b[e];
                    }
                    u32x4 w; w.x = pk2(v[0], v[1]); w.y = pk2(v[2], v[3]); w.z = pk2(v[4], v[5]); w.w = pk2(v[6], v[7]);
                    *(u32x4*)rowp = w;
                } else {
                    const float rs = rowscale ? rowscale[r] : 1.f;
#pragma unroll
                    for (int bj = 0; bj < 2; ++bj) { const f32x4 v0 = acc[ai][bj][m][0] * rs, v1 = acc[ai][bj][m][1] * rs;
                        u32x4 w; w.x = pk2(v0[0], v0[1]); w.y = pk2(v0[2], v0[3]); w.z = pk2(v1[0], v1[1]); w.w = pk2(v1[2], v1[3]);
                        *(u32x4*)(rowp + bj * HALF) = w; }
                }
            }
    }
};

struct EpiQ {
    static constexpr bool PERM = true;
    bf16_t* O; int ldc; const float* rowscale; const f32x4* cs;
    DI void operator()(const f32x4 (&acc)[2][2][4][2], const Unit& u, int wr, int wc, int fr, int fq) const {
        const int row0 = u.pm * BM + wr * 64 + fr;
        const float sgn = (fq < 2) ? -1.f : 1.f;
#pragma unroll
        for (int ai = 0; ai < 2; ++ai)
#pragma unroll
            for (int m = 0; m < 4; ++m) {
                const int r = row0 + ai * HALF + m * 16;
                const float rs = rowscale[r];
                bf16_t* rowp = O + (size_t)r * ldc + u.pn * BM + wc * 32 + 8 * fq;
#pragma unroll
                for (int bj = 0; bj < 2; ++bj) {
                    const int cgp = 8 * u.pn + 4 * bj + wc;
                    const bool rope = (cgp < 36) && (cgp % 3 == 2);
                    float v[8];
#pragma unroll
                    for (int e = 0; e < 4; ++e) { v[e] = acc[ai][bj][m][0][e] * rs; v[4 + e] = acc[ai][bj][m][1][e] * rs; }
                    if (rope) {
                        const f32x4* cp = cs + (size_t)r * 8 + 4 * (fq & 1);
#pragma unroll
                        for (int e2 = 0; e2 < 4; ++e2) { const f32x4 c4 = cp[e2];
                            const float p0 = __shfl_xor(v[2 * e2], 32), p1 = __shfl_xor(v[2 * e2 + 1], 32);
                            v[2 * e2] = v[2 * e2] * c4[0] + sgn * p0 * c4[1]; v[2 * e2 + 1] = v[2 * e2 + 1] * c4[2] + sgn * p1 * c4[3]; }
                    }
                    u32x4 w; w.x = pk2(v[0], v[1]); w.y = pk2(v[2], v[3]); w.z = pk2(v[4], v[5]); w.w = pk2(v[6], v[7]);
                    *(u32x4*)(rowp + bj * HALF) = w;
                }
                asm volatile("" ::: "memory");
            }
    }
};

struct EpiColScale {
    static constexpr bool PERM = true;
    bf16_t* O; int ldc; const float* colscale;
    DI void operator()(const f32x4 (&acc)[2][2][4][2], const Unit& u, int wr, int wc, int fr, int fq) const {
        const int row0 = u.pm * BM + wr * 64 + fr;
        const int col0 = u.pn * BM + wc * 32 + 8 * fq;
        const f32x4 s00 = *(const f32x4*)(colscale + col0), s01 = *(const f32x4*)(colscale + col0 + 4);
        const f32x4 s10 = *(const f32x4*)(colscale + col0 + HALF), s11 = *(const f32x4*)(colscale + col0 + HALF + 4);
#pragma unroll
        for (int ai = 0; ai < 2; ++ai)
#pragma unroll
            for (int m = 0; m < 4; ++m) {
                bf16_t* rowp = O + (size_t)(row0 + ai * HALF + m * 16) * ldc + col0;
#pragma unroll
                for (int bj = 0; bj < 2; ++bj) {
                    const f32x4 v0 = acc[ai][bj][m][0] * (bj ? s10 : s00), v1 = acc[ai][bj][m][1] * (bj ? s11 : s01);
                    u32x4 w; w.x = pk2(v0[0], v0[1]); w.y = pk2(v0[2], v0[3]); w.z = pk2(v1[0], v1[1]); w.w = pk2(v1[2], v1[3]);
                    *(u32x4*)(rowp + bj * HALF) = w;
                }
                asm volatile("" ::: "memory");
            }
    }
};

struct EpiMemKV {
    static constexpr bool PERM = true;
    bf16_t* Kp; bf16_t* Vt;
    DI void operator()(const f32x4 (&acc)[2][2][4][2], const Unit& u, int wr, int wc, int fr, int fq) const {
        const int row0 = wr * 64 + fr, c0 = wc * 32 + 8 * fq;
#pragma unroll
        for (int ai = 0; ai < 2; ++ai)
#pragma unroll
            for (int m = 0; m < 4; ++m) {
                const int r = row0 + ai * HALF + m * 16;
#pragma unroll
                for (int bj = 0; bj < 2; ++bj) {
                    const f32x4 v0 = acc[ai][bj][m][0], v1 = acc[ai][bj][m][1];
                    if (u.pn == 0) {
                        u32x4 w; w.x = pk2(v0[0], v0[1]); w.y = pk2(v0[2], v0[3]); w.z = pk2(v1[0], v1[1]); w.w = pk2(v1[2], v1[3]);
                        *(u32x4*)(Kp + (size_t)r * 256 + c0 + bj * HALF) = w;
                    } else {
                        bf16_t* vp = Vt + (size_t)(c0 + bj * HALF) * 256 + r;
#pragma unroll
                        for (int e = 0; e < 4; ++e) { vp[e * 256] = (bf16_t)(pk2(v0[e], 0.f) & 0xffffu); vp[(4 + e) * 256] = (bf16_t)(pk2(v1[e], 0.f) & 0xffffu); }
                    }
                }
                asm volatile("" ::: "memory");
            }
    }
};

template <class Epi>
DI void gemm_phase(LAS unsigned char* lds, const Gemm g, const StaticOrder& S, const Epi& E, const int tid) {
    const int wid = __builtin_amdgcn_readfirstlane(tid >> 6), lane = tid & 63, wr = wid >> 2, wc = wid & 3, fr = lane & 15, fq = lane >> 4;
    int K = g.K; asm volatile("" : "+s"(K));
    const int nt = K / BK;
    unsigned voffA[2], voffB[2];
#pragma unroll
    for (int i = 0; i < 2; ++i) { int R, C; stage_rc(tid * 16 + i * 8192, R, C); const int Rb = Epi::PERM ? ((R & ~31) + perm32(R & 31)) : R;
        voffA[i] = (unsigned)(R * g.lda + C) * 2u; voffB[i] = (unsigned)(Rb * g.ldb + C) * 2u; }
    const size_t kstep = (size_t)(BK * 2);
    const size_t hstepA = (size_t)HALF * g.lda * 2, tstepA = 2 * hstepA;
    const size_t hstepB = (size_t)HALF * g.ldb * 2, tstepB = 2 * hstepB;
    const unsigned ldsw = (unsigned)wid * 1024u;
    const int aoff = lds_byte(wr * 64 + fr, fq * 8), boff = lds_byte(wc * 32 + fr, fq * 8);
#define PG8_SA(b, h) (((b) * 2 + (h)) * HTB)
#define PG8_SB(b, h) ((4 + (b) * 2 + (h)) * HTB)
#define PG8_STAGE(bufoff, gbase, voff) do { _Pragma("unroll") for (int _i = 0; _i < 2; ++_i) \
        __builtin_amdgcn_global_load_lds((const unsigned*)((const char*)(gbase) + (voff)[_i]), (LAS unsigned*)(lds + (bufoff) + ldsw + _i * 8192), 16, 0, 0); } while (0)
#define PG8_LDA(dst, b, h) do { _Pragma("unroll") for (int m = 0; m < 4; ++m) _Pragma("unroll") for (int k = 0; k < 2; ++k) dst[m][k] = *(const LAS bf16x8*)(lds + PG8_SA(b, h) + aoff + m * 2048 + k * 1024); } while (0)
#define PG8_LDB(dst, b, h) do { _Pragma("unroll") for (int n = 0; n < 2; ++n) _Pragma("unroll") for (int k = 0; k < 2; ++k) dst[n][k] = *(const LAS bf16x8*)(lds + PG8_SB(b, h) + boff + n * 2048 + k * 1024); } while (0)
#define PG8_MMA(ai, bj, At, Bt) do { __builtin_amdgcn_s_setprio(1); _Pragma("unroll") for (int m = 0; m < 4; ++m) _Pragma("unroll") for (int n = 0; n < 2; ++n) _Pragma("unroll") for (int k = 0; k < 2; ++k) \
        acc[ai][bj][m][n] = __builtin_amdgcn_mfma_f32_16x16x32_bf16(Bt[n][k], At[m][k], acc[ai][bj][m][n], 0, 0, 0); __builtin_amdgcn_s_setprio(0); } while (0)
#define PG8_WAIT_V(n) asm volatile("s_waitcnt vmcnt(" #n ")" ::: "memory")
#define PG8_WAIT_L(n) asm volatile("s_waitcnt lgkmcnt(" #n ")" ::: "memory")
#define PG8_BAR __builtin_amdgcn_s_barrier()
#define PG8_SCHED __builtin_amdgcn_sched_barrier(0)
    Unit cur, nxt; int ui = 0;
    if (!S.next(0, cur)) return;
    f32x4 acc[2][2][4][2];
#pragma unroll
    for (int a = 0; a < 2; ++a)
#pragma unroll
        for (int b = 0; b < 2; ++b)
#pragma unroll
            for (int m = 0; m < 4; ++m)
#pragma unroll
                for (int n = 0; n < 2; ++n) acc[a][b][m][n] = (f32x4){0.f, 0.f, 0.f, 0.f};
    bf16x8 At[4][2], B0[2][2], B1[2][2];
    const char* cA = (const char*)g.A + (size_t)cur.pm * tstepA; const char* cB = (const char*)g.Bt + (size_t)cur.pn * tstepB;
    PG8_STAGE(PG8_SB(0, 0), cB, voffB); PG8_STAGE(PG8_SB(0, 1), cB + hstepB, voffB); PG8_STAGE(PG8_SA(0, 0), cA, voffA); PG8_STAGE(PG8_SA(0, 1), cA + hstepA, voffA);
    if (wr == 1) PG8_BAR;
    PG8_WAIT_V(2); PG8_BAR;
    PG8_STAGE(PG8_SB(1, 0), cB + kstep, voffB); PG8_STAGE(PG8_SA(1, 0), cA + kstep, voffA); PG8_STAGE(PG8_SB(1, 1), cB + hstepB + kstep, voffB);
    PG8_WAIT_V(6); PG8_BAR;
    for (;;) {
        const bool has_next = S.next(ui + 1, nxt);
        const char* nA = has_next ? (const char*)g.A + (size_t)nxt.pm * tstepA : cA; const char* nB = has_next ? (const char*)g.Bt + (size_t)nxt.pn * tstepB : cB;
        for (int t = 0; t < nt; t += 2) {
            const bool last = (t == nt - 2);
            const char* a1 = cA + (size_t)(t + 1) * kstep;
            const char* a2 = last ? nA : cA + (size_t)(t + 2) * kstep; const char* b2 = last ? nB : cB + (size_t)(t + 2) * kstep;
            const char* a3 = a2 + kstep; const char* b3 = b2 + kstep;
            PG8_LDB(B0, 0, 0); PG8_LDB(B1, 0, 1); PG8_SCHED; PG8_LDA(At, 0, 0); PG8_STAGE(PG8_SA(1, 1), a1 + hstepA, voffA);
            PG8_WAIT_V(8); PG8_WAIT_L(0); PG8_BAR; PG8_MMA(0, 0, At, B0); PG8_MMA(0, 1, At, B1); PG8_BAR; PG8_SCHED;
            PG8_LDA(At, 0, 1); PG8_STAGE(PG8_SB(0, 0), b2, voffB); PG8_STAGE(PG8_SB(0, 1), b2 + hstepB, voffB); PG8_STAGE(PG8_SA(0, 0), a2, voffA);
            PG8_WAIT_V(8); PG8_WAIT_L(0); PG8_BAR; PG8_MMA(1, 0, At, B0); PG8_MMA(1, 1, At, B1); PG8_BAR; PG8_SCHED;
            PG8_LDB(B0, 1, 0); PG8_LDB(B1, 1, 1); PG8_SCHED; PG8_LDA(At, 1, 0); PG8_STAGE(PG8_SA(0, 1), a2 + hstepA, voffA);
            PG8_WAIT_V(8); PG8_WAIT_L(0); PG8_BAR; PG8_MMA(0, 0, At, B0); PG8_MMA(0, 1, At, B1); PG8_BAR; PG8_SCHED;
            PG8_LDA(At, 1, 1); PG8_STAGE(PG8_SB(1, 0), b3, voffB); PG8_STAGE(PG8_SB(1, 1), b3 + hstepB, voffB); PG8_STAGE(PG8_SA(1, 0), a3, voffA);
            PG8_WAIT_V(8); PG8_WAIT_L(0); PG8_BAR; PG8_MMA(1, 0, At, B0); PG8_MMA(1, 1, At, B1); PG8_BAR; PG8_SCHED;
        }
        if (wr == 0) PG8_BAR;
        { int fr2 = fr, fq2 = fq; asm volatile("" : "+v"(fr2), "+v"(fq2)); E(acc, cur, wr, wc, fr2, fq2); }
        if (!has_next) break;
#pragma unroll
        for (int a = 0; a < 2; ++a)
#pragma unroll
            for (int b = 0; b < 2; ++b)
#pragma unroll
                for (int m = 0; m < 4; ++m)
#pragma unroll
                    for (int n = 0; n < 2; ++n) acc[a][b][m][n] = (f32x4){0.f, 0.f, 0.f, 0.f};
        cur = nxt; cA = nA; cB = nB; ++ui;
        if (wr == 1) PG8_BAR;
    }
    PG8_WAIT_V(0);
    PG8_BAR;
#undef PG8_SA
#undef PG8_SB
#undef PG8_STAGE
#undef PG8_LDA
#undef PG8_LDB
#undef PG8_MMA
#undef PG8_WAIT_V
#undef PG8_WAIT_L
#undef PG8_BAR
#undef PG8_SCHED
}
}

#define MFMA32(a, b, c) __builtin_amdgcn_mfma_f32_32x32x16_bf16((a), (b), (c), 0, 0, 0)
template <int KS, class SF>
DI void attn_tile(const LAS unsigned char* Kt, const int kstr, const LAS unsigned char* Vt, const int vstr,
                  const bf16x8 (&qf)[KS], f32x16 (&o)[2], float& m, float& l, const int l32, const int hl, SF sf) {
    f32x16 st[2];
#pragma unroll
    for (int kb = 0; kb < 2; ++kb) {
        f32x16 a;
#pragma unroll
        for (int i = 0; i < 16; ++i) a[i] = 0.f;
        const LAS unsigned char* kp = Kt + (32 * kb + l32) * kstr + 16 * hl;
#pragma unroll
        for (int s = 0; s < KS; ++s) a = MFMA32(*(const LAS bf16x8*)(kp + 32 * s), qf[s], a);
        st[kb] = a;
    }
    float mx = -INFINITY;
#pragma unroll
    for (int kb = 0; kb < 2; ++kb)
#pragma unroll
        for (int j = 0; j < 16; ++j) { const float v = sf(st[kb][j], 32 * kb + (j & 3) + 8 * (j >> 2) + 4 * hl); st[kb][j] = v; mx = fmaxf(mx, v); }
    mx = fmaxf(mx, __shfl_xor(mx, 32));
    const float mn = fmaxf(m, mx);
    const float ms = (mn == -INFINITY) ? 0.f : mn;
    const float alpha = fexp2(m - ms);
    float ps = 0.f;
#pragma unroll
    for (int kb = 0; kb < 2; ++kb)
#pragma unroll
        for (int j = 0; j < 16; ++j) { const float p = fexp2(st[kb][j] - ms); st[kb][j] = p; ps += p; }
    ps += __shfl_xor(ps, 32);
    l = l * alpha + ps; m = mn;
#pragma unroll
    for (int db = 0; db < 2; ++db)
#pragma unroll
        for (int i = 0; i < 16; ++i) o[db][i] *= alpha;
#pragma unroll
    for (int kb = 0; kb < 2; ++kb)
#pragma unroll
        for (int s2 = 0; s2 < 2; ++s2) {
            u32x4 pw;
            pw.x = pk2(st[kb][8 * s2 + 0], st[kb][8 * s2 + 1]); pw.y = pk2(st[kb][8 * s2 + 2], st[kb][8 * s2 + 3]);
            pw.z = pk2(st[kb][8 * s2 + 4], st[kb][8 * s2 + 5]); pw.w = pk2(st[kb][8 * s2 + 6], st[kb][8 * s2 + 7]);
            const bf16x8 pb = __builtin_bit_cast(bf16x8, pw);
#pragma unroll
            for (int db = 0; db < 2; ++db) {
                const LAS unsigned char* vp = Vt + (32 * db + l32) * vstr + (32 * kb + 16 * s2 + 4 * hl) * 2;
                const s16x4 lo = *(const LAS s16x4*)vp, hi = *(const LAS s16x4*)(vp + 16);
                const bf16x8 va = __builtin_shufflevector(lo, hi, 0, 1, 2, 3, 4, 5, 6, 7);
                o[db] = MFMA32(va, pb, o[db]);
            }
        }
}
DI void attn_store(bf16_t* orow, const f32x16 (&o)[2], const float inv, const int hl) {
#pragma unroll
    for (int db = 0; db < 2; ++db)
#pragma unroll
        for (int gq = 0; gq < 4; ++gq) { u32x2 w; w.x = pk2(o[db][4 * gq] * inv, o[db][4 * gq + 1] * inv); w.y = pk2(o[db][4 * gq + 2] * inv, o[db][4 * gq + 3] * inv);
            *(u32x2*)(orow + 32 * db + 8 * gq + 4 * hl) = w; }
}

#define XB_TMO      128
#define XB_XCNT(j)  (256  + 64 * (j))
#define XB_XSUB(j)  (1280 + 64 * (j))
#define XB_XGEN(j)  (2304 + 64 * (j))
#define XB_TOP      3328
#define XB_TOPGEN   3392
#define XCD_BAR_WORDS 3456
#define XB_SPIN_CAP (1u << 18)
DI unsigned xb_ld(unsigned* p)              { return __hip_atomic_load(p, __ATOMIC_RELAXED, __HIP_MEMORY_SCOPE_AGENT); }
DI unsigned xb_add(unsigned* p, unsigned v) { return __hip_atomic_fetch_add(p, v, __ATOMIC_RELAXED, __HIP_MEMORY_SCOPE_AGENT); }
DI unsigned xb_xcc_id() { return (unsigned)__builtin_amdgcn_s_getreg((3 << 11) | 20) & 0xFu; }
#define XB_SPIN(cond, bar) do { unsigned _sp = 0; while (cond) { __builtin_amdgcn_s_sleep(1); \
    if ((++_sp & 255u) == 0u) { if (xb_ld(&(bar)[XB_TMO])) break; if (_sp > XB_SPIN_CAP) { atomicAdd(&(bar)[XB_TMO], 1u); break; } } } } while (0)
struct XcdBarrier { unsigned* bar; unsigned x; volatile LAS unsigned* st; };
DI void xcd_barrier_complete(unsigned* bar, unsigned x, unsigned& nloc, unsigned& nx) {
    const unsigned G = gridDim.x * gridDim.y * gridDim.z;
    unsigned sum, cnt, mine, sp = 0u;
    for (;;) {
        sum = 0u; cnt = 0u; mine = 0u;
#pragma unroll
        for (unsigned j = 0; j < 16; ++j) { const unsigned c = xb_ld(&bar[XB_XCNT(j)]); sum += c; cnt += (c > 0u) ? 1u : 0u; mine = (j == x) ? c : mine; }
        if (sum == G) break;
        __builtin_amdgcn_s_sleep(1);
        if ((++sp & 255u) == 0u) { if (xb_ld(&bar[XB_TMO])) break; if (sp > XB_SPIN_CAP) { atomicAdd(&bar[XB_TMO], 1u); break; } }
    }
    nloc = mine > 0u ? mine : 1u; nx = cnt > 0u ? cnt : 1u;
}
DI void xcd_barrier(const XcdBarrier& b, const int tid) {
    asm volatile("s_waitcnt vmcnt(0)" ::: "memory");
    __syncthreads();
    if (tid == 0) {
        unsigned* bar = b.bar;
        __builtin_amdgcn_s_waitcnt(0);
        unsigned nloc = b.st[0], nx = b.st[1];
        if (nloc == 0u) { xcd_barrier_complete(bar, b.x, nloc, nx); b.st[0] = nloc; b.st[1] = nx; }
        const unsigned old = xb_add(&bar[XB_XSUB(b.x)], 1u);
        const unsigned gen = old / nloc;
        if (old + 1u == (gen + 1u) * nloc) {
            __builtin_amdgcn_fence(__ATOMIC_RELEASE, "agent");
            asm volatile("s_waitcnt vmcnt(0)" ::: "memory");
            const unsigned og = xb_add(&bar[XB_TOP], 1u);
            const unsigned tg = og / nx;
            if (og + 1u == (tg + 1u) * nx) xb_add(&bar[XB_TOPGEN], 1u);
            else XB_SPIN(xb_ld(&bar[XB_TOPGEN]) == tg, bar);
            __builtin_amdgcn_fence(__ATOMIC_ACQUIRE, "agent");
            xb_add(&bar[XB_XGEN(b.x)], 1u);
            asm volatile("s_waitcnt vmcnt(0)" ::: "memory");
        } else {
            XB_SPIN(xb_ld(&bar[XB_XGEN(b.x)]) == gen, bar);
            __builtin_amdgcn_fence(__ATOMIC_ACQUIRE, "agent");
            asm volatile("s_waitcnt vmcnt(0)" ::: "memory");
        }
    }
    __syncthreads();
}

struct Args { const void* in[25]; float* out; unsigned char* ws; int lo, hi; };

DI void row_op(const float* xin, float* xout, const float* Y, const float* gA, const float sc, const float* gB, bf16_t* hb, const int lane) {
    f32x4 v[4];
#pragma unroll
    for (int j = 0; j < 4; ++j) v[j] = ((const f32x4*)xin)[lane + 64 * j];
    if (Y) {
        f32x4 y[4]; float ss = 0.f;
#pragma unroll
        for (int j = 0; j < 4; ++j) { y[j] = ((const f32x4*)Y)[lane + 64 * j]; ss += (y[j][0] * y[j][0] + y[j][1] * y[j][1]) + (y[j][2] * y[j][2] + y[j][3] * y[j][3]); }
        ss = wave_sum(ss);
        const float ri = sc / sqrtf(ss * (1.f / 1024.f) + EPS);
#pragma unroll
        for (int j = 0; j < 4; ++j) { const f32x4 gv = ((const f32x4*)gA)[lane + 64 * j]; v[j] += y[j] * gv * ri; }
    }
    if (xout) {
#pragma unroll
        for (int j = 0; j < 4; ++j) ((f32x4*)xout)[lane + 64 * j] = v[j];
    }
    if (gB) {
        float ss = 0.f;
#pragma unroll
        for (int j = 0; j < 4; ++j) ss += (v[j][0] * v[j][0] + v[j][1] * v[j][1]) + (v[j][2] * v[j][2] + v[j][3] * v[j][3]);
        ss = wave_sum(ss);
        const float ri = 1.f / sqrtf(ss * (1.f / 1024.f) + EPS);
#pragma unroll
        for (int j = 0; j < 4; ++j) { const f32x4 gv = ((const f32x4*)gB)[lane + 64 * j]; const f32x4 ov = v[j] * gv * ri;
            u32x2 w; w.x = pk2(ov[0], ov[1]); w.y = pk2(ov[2], ov[3]); ((u32x2*)hb)[lane + 64 * j] = w; }
    }
}

DI int map_row(const int kind, const int nr) {
    if (kind == 0) return nr;
    if (kind == 1) return 256 * (nr >> 7) + (nr & 127);
    const int h = nr >> 7, w = nr & 127; return (w < 64) ? 64 * h + w : 768 + 64 * h + (w - 64);
}
DI void xpose_seg(const float* W, const int ldw, const int K, const int col0, const int ncols, bf16_t* WT, const int ldt, const int drow0, const int kind,
                  const float* gain, LAS float* scr, int& base, const int gw, const int NGW, const int lane) {
    const int nblk = ncols >> 5, nitems = (K >> 6) * nblk;
    int start = (gw - (base % NGW) + NGW) % NGW;
    for (int it = start; it < nitems; it += NGW) {
        const int kb = it / nblk, nb = it - kb * nblk, k0 = 64 * kb, n0 = 32 * nb;
#pragma unroll 8
        for (int i = 0; i < 32; ++i) { const int kk = 2 * i + (lane >> 5); float w = W[(size_t)(k0 + kk) * ldw + col0 + n0 + (lane & 31)]; if (gain) w *= gain[k0 + kk]; scr[kk * 33 + (lane & 31)] = w; }
        asm volatile("s_waitcnt lgkmcnt(0)" ::: "memory");
        const int c = lane & 7;
#pragma unroll
        for (int j = 0; j < 4; ++j) { const int n = (lane >> 3) + 8 * j; const LAS float* s = scr + (8 * c) * 33 + n;
            u32x4 o; o.x = pk2(s[0 * 33], s[1 * 33]); o.y = pk2(s[2 * 33], s[3 * 33]); o.z = pk2(s[4 * 33], s[5 * 33]); o.w = pk2(s[6 * 33], s[7 * 33]);
            *(u32x4*)(WT + (size_t)(drow0 + map_row(kind, n0 + n)) * ldt + k0 + 8 * c) = o; }
        asm volatile("s_waitcnt lgkmcnt(0)" ::: "memory");
    }
    base += nitems;
}

__global__ void __launch_bounds__(NTHREADS, 2) fwd_megakernel(Args args) {
    extern __shared__ __attribute__((aligned(16))) unsigned char lds_raw[];
    LAS unsigned char* lds = (LAS unsigned char*)lds_raw;
    cg::grid_group grid = cg::this_grid();
    const int G = gridDim.x;
    const int wave_s = __builtin_amdgcn_readfirstlane((int)(threadIdx.x >> 6));
    volatile LAS unsigned* xst = (volatile LAS unsigned*)(lds + (LDS_BYTES - 16));
    if (threadIdx.x < 4) xst[threadIdx.x] = 0u;
    __syncthreads();
    XcdBarrier xbar; xbar.bar = (unsigned*)(args.ws + WS_BAR); xbar.x = xb_xcc_id(); xbar.st = xst;
    if (threadIdx.x == 0 && args.hi - args.lo > 1) (void)xb_add(&xbar.bar[XB_XCNT(xbar.x)], 1u);
    bool first_seam = true;
#define xres (args.out)
#define in_x ((const float*)args.in[0])
#define in_mem ((const float*)args.in[1])
#define in_pos ((const int*)args.in[2])
#define norm_g ((const float*)args.in[3])
#define CS ((f32x2*)(ws + WS_CS))
#define RINVQ ((float*)(ws + WS_RINVQ))
#define RINVK ((float*)(ws + WS_RINVK))
#define MEMK ((bf16_t*)(ws + WS_MEMK))
#define MEMVT ((bf16_t*)(ws + WS_MEMVT))
#define MEMN ((bf16_t*)(ws + WS_MEMN))
#define KR ((bf16_t*)(ws + WS_KR))
#define LSE ((float*)(ws + WS_LSE))
#define WGU ((bf16_t*)(ws + WS_WGU))
#define WD ((bf16_t*)(ws + WS_WD))
#define WIN ((bf16_t*)(ws + WS_WIN))
#define WOUT ((bf16_t*)(ws + WS_WOUT))
#define WUQ ((bf16_t*)(ws + WS_WUQ))
#define WUKV ((bf16_t*)(ws + WS_WUKV))
#define WMKV ((bf16_t*)(ws + WS_WMKV))
#define HB ((bf16_t*)(ws + WS_HB))
#define CAT ((bf16_t*)(ws + WS_CAT))
#define OG ((bf16_t*)(ws + WS_AUX))
#define Z ((bf16_t*)(ws + WS_Z))
#define Y ((float*)(ws + WS_Z + ZO_Y))
#define QB ((bf16_t*)(ws + WS_Z + ZO_Q))
#define KN ((bf16_t*)(ws + WS_Z + ZO_KN))
#define VT ((bf16_t*)(ws + WS_Z + ZO_VT))

    for (int opi = args.lo; opi < args.hi; ++opi) {
        int lane; asm volatile("v_mbcnt_lo_u32_b32 %0, -1, 0\n\tv_mbcnt_hi_u32_b32 %0, -1, %0" : "=v"(lane));
        int bx = blockIdx.x; asm volatile("" : "+s"(bx));
        unsigned char* ws = args.ws; asm volatile("" : "+s"(ws));
        const int wave = wave_s, tid = wave * 64 + lane;
        const int gw = bx * NWAVES + wave, NGW = G * NWAVES;
#define l32 (lane & 31)
#define hl (lane >> 5)
        const unsigned op = D_OPS.v[opi];
        const int kind = op & 255, L = (op >> 8) & 255, f = (op >> 16) & 255, dosync = (op >> 24) & 1;
        switch (kind) {
        case K_P0: {
            for (int r = gw; r < S; r += NGW) row_op(in_x + (size_t)r * DM, xres + (size_t)r * DM, nullptr, nullptr, 0.f, norm_g, HB + (size_t)r * DM, lane);
            for (int idx = bx * NTHREADS + tid; idx < S * 16; idx += G * NTHREADS) {
                const int t = idx >> 4, i = idx & 15;
                const float ang = (float)in_pos[t] * INVF[i];
                const float kf = rintf(ang * 0.15915494309189535f);
                const float rr = (float)((double)ang - (double)kf * 6.283185307179586);
                CS[idx] = (f32x2){cosf(rr), sinf(rr)};
            }
        } break;
        case K_PREP: {
            for (int r = gw; r < 256; r += NGW) row_op(in_mem + (size_t)r * DM, nullptr, nullptr, nullptr, 0.f, norm_g + (size_t)(L * 7 + 6) * DM, MEMN + (size_t)r * DM, lane);
            LAS float* scr = (LAS float*)(lds + wave * 16384);
            int base = 0;
            for (int ff = 0; ff < 2; ++ff) {
                const float* wg = (const float*)args.in[4] + (size_t)(L * 2 + ff) * DM * FF;
                const float* wu = (const float*)args.in[5] + (size_t)(L * 2 + ff) * DM * FF;
                const float* wd = (const float*)args.in[6] + (size_t)(L * 2 + ff) * FF * DM;
                xpose_seg(wg, FF, DM, 0, FF, WGU + (size_t)ff * 5632 * DM, DM, 0, 1, nullptr, scr, base, gw, NGW, lane);
                xpose_seg(wu, FF, DM, 0, FF, WGU + (size_t)ff * 5632 * DM, DM, 128, 1, nullptr, scr, base, gw, NGW, lane);
                xpose_seg(wd, DM, FF, 0, DM, WD + (size_t)ff * DM * FF, FF, 0, 0, nullptr, scr, base, gw, NGW, lane);
            }
            xpose_seg((const float*)args.in[7] + (size_t)L * DM * 512, 512, DM, 0, 512, WMKV, DM, 0, 0, nullptr, scr, base, gw, NGW, lane);
            if (L == 0) {
                xpose_seg((const float*)args.in[8], 928, DM, 0, 928, WIN, DM, 0, 0, nullptr, scr, base, gw, NGW, lane);
                xpose_seg((const float*)args.in[11], 1152, 384, 0, 1152, WUQ, 384, 0, 0, (const float*)args.in[9], scr, base, gw, NGW, lane);
                xpose_seg((const float*)args.in[12], 1536, 256, 0, 1536, WUKV, 256, 0, 2, (const float*)args.in[10], scr, base, gw, NGW, lane);
                xpose_seg((const float*)args.in[13], DM, DM, 0, DM, WOUT, DM, 0, 0, nullptr, scr, base, gw, NGW, lane);
                for (int idx = bx * NTHREADS + tid; idx < (96 * 1024 + 128 * 384) / 8; idx += G * NTHREADS) {
                    unsigned z0 = 0u; asm volatile("" : "+v"(z0));
                    const u32x4 zz = {z0, z0, z0, z0};
                    if (idx < 96 * 1024 / 8) *(u32x4*)(WIN + (size_t)928 * DM + (size_t)idx * 8) = zz;
                    else *(u32x4*)(WUQ + (size_t)1152 * 384 + (size_t)(idx - 96 * 1024 / 8) * 8) = zz;
                }
            } else if (L == 1) {
                xpose_seg((const float*)args.in[14], 4864, DM, 0, 4864, WIN, DM, 0, 0, nullptr, scr, base, gw, NGW, lane);
                xpose_seg((const float*)args.in[15], DM, 768, 0, DM, WOUT, 768, 0, 0, nullptr, scr, base, gw, NGW, lane);
            } else if (L == 2) {
                const float* w = (const float*)args.in[16];
                xpose_seg(w, 1792, DM, 0, 768, WIN, DM, 0, 1, nullptr, scr, base, gw, NGW, lane);
                xpose_seg(w, 1792, DM, 768, 768, WIN, DM, 128, 1, nullptr, scr, base, gw, NGW, lane);
                xpose_seg(w, 1792, DM, 1536, 256, WIN, DM, 1536, 0, nullptr, scr, base, gw, NGW, lane);
                xpose_seg((const float*)args.in[21], DM, DM, 0, DM, WOUT, DM, 0, 0, nullptr, scr, base, gw, NGW, lane);
            } else {
                const float* w = (const float*)args.in[22];
                xpose_seg(w, 2560, DM, 0, 768, WIN, DM, 0, 0, nullptr, scr, base, gw, NGW, lane);
                xpose_seg(w, 2560, DM, 768, 768, WIN, DM, 768, 1, nullptr, scr, base, gw, NGW, lane);
                xpose_seg(w, 2560, DM, 1536, 768, WIN, DM, 768 + 128, 1, nullptr, scr, base, gw, NGW, lane);
                xpose_seg(w, 2560, DM, 2304, 256, WIN, DM, 2304, 0, nullptr, scr, base, gw, NGW, lane);
                xpose_seg((const float*)args.in[24], DM, DM, 0, DM, WOUT, DM, 0, 0, nullptr, scr, base, gw, NGW, lane);
            }
        } break;
        case K_MEMKV: {
            pg8::Gemm g{MEMN, WMKV, 256, 512, DM, DM, DM}; pg8::StaticOrder so; so.init(256, 512, G, bx);
            pg8::EpiMemKV E{MEMK, MEMVT};
            pg8::gemm_phase<pg8::EpiMemKV>(lds, g, so, E, tid);
        } break;
        case K_GU: case K_INPROJ: case K_UPK: {
            pg8::Gemm g; pg8::EpiPair E; int c = bx;
            if (kind == K_GU) { g = pg8::Gemm{HB, WGU + (size_t)f * 5632 * DM, S, 5632, DM, DM, DM}; E = pg8::EpiPair{Z, FF, 0, 22, 0, nullptr}; }
            else if (kind == K_UPK) { g = pg8::Gemm{Z + 384, WUKV, S, 768, 256, DM, 256}; E = pg8::EpiPair{KN, 768, 0, 0, 0, RINVK}; c = (bx + 192) % G; }
            else {
                const int N = (L == 0) ? 1024 : (L == 1 ? 4864 : (L == 2 ? 1792 : 2560));
                const int ldz = (L == 0) ? 1024 : (L == 1 ? 4864 : (L == 2 ? 1024 : 1792));
                const int plo = (L == 3) ? 3 : 0, phi = (L == 2) ? 6 : (L == 3 ? 9 : 0), pop = (L == 2) ? 1 : 2;
                g = pg8::Gemm{HB, WIN, S, N, DM, DM, DM}; E = pg8::EpiPair{Z, ldz, plo, phi, pop, nullptr};
            }
            pg8::StaticOrder so; so.init(g.M, g.N, G, c);
            pg8::gemm_phase<pg8::EpiPair>(lds, g, so, E, tid);
        } break;
        case K_DOWN: case K_OUTPROJ: {
            pg8::Gemm g;
            if (kind == K_DOWN) g = pg8::Gemm{Z, WD + (size_t)f * DM * FF, S, DM, FF, FF, FF};
            else { const int kk = (L == 1) ? 768 : 1024; g = pg8::Gemm{CAT, WOUT, S, DM, kk, kk, kk}; }
            pg8::StaticOrder so; so.init(g.M, g.N, G, bx);
            pg8::EpiF32 E{Y, DM};
            pg8::gemm_phase<pg8::EpiF32>(lds, g, so, E, tid);
        } break;
        case K_ROW: {
            const float* gl = norm_g + (size_t)L * 7 * DM;
            const float* gA = gl + (f == 0 ? 1 : (f == 1 ? 3 : 5)) * DM;
            const float* gB = (f == 0) ? gl + 2 * DM : (f == 1 ? gl + 4 * DM : (L < 3 ? gl + 7 * DM : nullptr));
            const float sc = (f == 1) ? 1.f : 0.5f;
            for (int r = gw; r < S; r += NGW) row_op(xres + (size_t)r * DM, xres + (size_t)r * DM, Y + (size_t)r * DM, gA, sc, gB, HB + (size_t)r * DM, lane);
        } break;
        case K_MLASTAT: {
            for (int r = gw; r < S; r += NGW) {
                const u32x4 a = *(const u32x4*)(Z + (size_t)r * DM + 8 * lane);
                const u32x4 b = *(const u32x4*)(Z + (size_t)r * DM + 512 + 8 * lane);
                float av[8], bv[8];
                av[0] = bflo(a.x); av[1] = bfhi(a.x); av[2] = bflo(a.y); av[3] = bfhi(a.y); av[4] = bflo(a.z); av[5] = bfhi(a.z); av[6] = bflo(a.w); av[7] = bfhi(a.w);
                bv[0] = bflo(b.x); bv[1] = bfhi(b.x); bv[2] = bflo(b.y); bv[3] = bfhi(b.y); bv[4] = bflo(b.z); bv[5] = bfhi(b.z); bv[6] = bflo(b.w); bv[7] = bfhi(b.w);
                float sa = 0.f, sb = 0.f;
#pragma unroll
                for (int e = 0; e < 8; ++e) { sa += av[e] * av[e]; sb += bv[e] * bv[e]; }
                const float ssq = wave_sum(lane < 48 ? sa : 0.f);
                const float ssk = wave_sum((lane >= 48 ? sa : 0.f) + (lane < 16 ? sb : 0.f));
                if (lane == 0) { RINVQ[r] = 1.f / sqrtf(ssq * (1.f / 384.f) + EPS); RINVK[r] = 1.f / sqrtf(ssk * (1.f / 256.f) + EPS); }
                float pv[8];
#pragma unroll
                for (int e = 0; e < 8; ++e) pv[e] = __shfl_xor(bv[e], 2);
                if (lane >= 16 && lane < 20) {
                    const int i0 = 8 * ((lane - 16) & 1);
                    const float sgn = (lane < 18) ? -1.f : 1.f;
                    float ov[8];
#pragma unroll
                    for (int e = 0; e < 8; ++e) { const f32x2 c2 = CS[(size_t)r * 16 + i0 + e]; ov[e] = bv[e] * c2[0] + sgn * pv[e] * c2[1]; }
                    u32x4 w; w.x = pk2(ov[0], ov[1]); w.y = pk2(ov[2], ov[3]); w.z = pk2(ov[4], ov[5]); w.w = pk2(ov[6], ov[7]);
                    *(u32x4*)(KR + (size_t)r * 32 + 8 * (lane - 16)) = w;
                }
            }
        } break;
        case K_MEMATT: {
            const int ldq = (L == 0) ? 1024 : (L == 1 ? 4864 : (L == 2 ? 1024 : 1792));
            const int qoff = (L == 0) ? 672 : (L == 1 ? 4608 : (L == 2 ? 768 : 1536));
            const int ldc = (L == 1) ? 768 : 1024, coff = (L == 1) ? 512 : 768;
            constexpr int KSTR = 144, VSTR = 520, KB = 256 * KSTR;
            const float cscale = 0.125f * LOG2E;
            for (int u = bx; u < 256; u += G) {
                const int h = u & 3, rb = u >> 2;
#pragma unroll
                for (int c4 = 0; c4 < 4; ++c4) {
                    const int chunk = tid + 512 * c4;
                    { const int key = chunk >> 3, c = chunk & 7; const u32x4 v = *(const u32x4*)(MEMK + (size_t)key * 256 + h * 64 + 8 * c); *(LAS u32x4*)(lds + key * KSTR + 16 * c) = v; }
                    { const int d = chunk >> 5, c = chunk & 31; const u32x4 v = *(const u32x4*)(MEMVT + (size_t)(h * 64 + d) * 256 + 8 * c);
                      LAS u32x2* dp = (LAS u32x2*)(lds + KB + d * VSTR + 16 * c); dp[0] = (u32x2){v.x, v.y}; dp[1] = (u32x2){v.z, v.w}; }
                }
                __syncthreads();
                const int q0 = rb * 256 + wave * 32;
                bf16x8 qf[4];
#pragma unroll
                for (int s = 0; s < 4; ++s) qf[s] = *(const bf16x8*)(Z + (size_t)(q0 + l32) * ldq + qoff + h * 64 + 16 * s + 8 * hl);
                f32x16 o[2];
#pragma unroll
                for (int i = 0; i < 16; ++i) { o[0][i] = 0.f; o[1][i] = 0.f; }
                float m = -INFINITY, l = 0.f;
#pragma unroll 1
                for (int t = 0; t < 4; ++t)
                    attn_tile<4>(lds + t * 64 * KSTR, KSTR, lds + KB + t * 128, VSTR, qf, o, m, l, l32, hl, [&](float v, int) { return v * cscale; });
                attn_store(CAT + (size_t)(q0 + l32) * ldc + coff + h * 64, o, 1.f / l, hl);
                __syncthreads();
            }
        } break;
        case K_UPQ: {
            pg8::Gemm g{Z, WUQ, S, 1280, 384, DM, 384}; pg8::StaticOrder so; so.init(S, 1280, G, bx);
            pg8::EpiQ E{QB, 1280, RINVQ, (const f32x4*)CS};
            pg8::gemm_phase<pg8::EpiQ>(lds, g, so, E, tid);
        } break;
        case K_UPV: {
            pg8::Gemm g{WUKV + (size_t)768 * 256, Z + 384, 768, S, 256, 256, DM}; pg8::StaticOrder so; so.init(768, S, G, bx);
            pg8::EpiColScale E{VT, S, RINVK};
            pg8::gemm_phase<pg8::EpiColScale>(lds, g, so, E, tid);
        } break;
        case K_MLAATT: {
            constexpr int KSTR = 208, VSTR = 136, KBYTES = 64 * KSTR, BUF = KBYTES + 64 * VSTR;
            const float cscale = 0.10206207261596577f * LOG2E;
            for (int i = 0;; ++i) {
                int u;
                if (G == 256) { if (i >= 3) break; u = 96 * (bx & 7) + 32 * i + (bx >> 3); } else { u = bx + i * G; if (u >= 768) break; }
                const int h = u >> 6, qb = u & 63;
                const int q0 = qb * 256 + wave * 32;
                bf16x8 qf[6];
#pragma unroll
                for (int s = 0; s < 6; ++s) qf[s] = *(const bf16x8*)(QB + (size_t)(q0 + l32) * 1280 + h * 96 + 16 * s + 8 * hl);
                f32x16 o[2];
#pragma unroll
                for (int k = 0; k < 16; ++k) { o[0][k] = 0.f; o[1][k] = 0.f; }
                float m = -INFINITY, l = 0.f;
                const int kkey = tid >> 3, kc = tid & 7, rkey = (tid >> 2) & 63, rc = tid & 3;
                const bf16_t* pkn = KN + (size_t)kkey * 768 + h * 64 + 8 * kc;
                const bf16_t* pkr = KR + (size_t)rkey * 32 + 8 * rc;
                const bf16_t* pvt = VT + (size_t)(h * 64 + kkey) * S + 8 * kc;
                const int dkn = kkey * KSTR + 16 * kc, dkr = rkey * KSTR + 128 + 16 * rc, dvt = KBYTES + kkey * VSTR + 16 * kc;
                u32x4 rkn = *(const u32x4*)pkn, rkr = *(const u32x4*)pkr, rvt = *(const u32x4*)pvt;
                { *(LAS u32x4*)(lds + dkn) = rkn; if (tid < 256) *(LAS u32x4*)(lds + dkr) = rkr;
                  LAS u32x2* dp = (LAS u32x2*)(lds + dvt); dp[0] = (u32x2){rvt.x, rvt.y}; dp[1] = (u32x2){rvt.z, rvt.w}; }
                __syncthreads();
#pragma unroll 1
                for (int t = 0; t < 256; ++t) {
                    const bool more = (t + 1 < 256);
                    if (more) { const size_t k1 = (size_t)(t + 1) * 64; rkn = *(const u32x4*)(pkn + k1 * 768); rkr = *(const u32x4*)(pkr + k1 * 32); rvt = *(const u32x4*)(pvt + k1); }
                    const LAS unsigned char* bufp = lds + (t & 1) * BUF;
                    attn_tile<6>(bufp, KSTR, bufp + KBYTES, VSTR, qf, o, m, l, l32, hl, [&](float v, int) { return v * cscale; });
                    if (more) { LAS unsigned char* nb = lds + ((t + 1) & 1) * BUF;
                        *(LAS u32x4*)(nb + dkn) = rkn; if (tid < 256) *(LAS u32x4*)(nb + dkr) = rkr;
                        LAS u32x2* dp = (LAS u32x2*)(nb + dvt); dp[0] = (u32x2){rvt.x, rvt.y}; dp[1] = (u32x2){rvt.z, rvt.w}; }
                    __syncthreads();
                }
                attn_store(CAT + (size_t)(q0 + l32) * 1024 + h * 64, o, 1.f / l, hl);
            }
        } break;
        case K_DILATT: {
            constexpr int KSTR = 144, VSTR = 776, VB = 384 * KSTR;
            const float cscale = 0.125f * LOG2E;
            for (int u = bx; u < 1536; u += G) {
                const int g = u >> 9, rem = u & 511, h = rem >> 6, w = rem & 63;
                const int lgd = 2 * g, dl = 1 << lgd, r = w & (dl - 1), q4 = w >> lgd, sub_len = S >> lgd;
                const int base_l = 256 * q4 - 64;
                const bf16_t* zk = Z + (size_t)(g * 3 + 1) * 512 + h * 64;
                const bf16_t* zv = Z + (size_t)(g * 3 + 2) * 512 + h * 64;
#pragma unroll 2
                for (int c6 = 0; c6 < 6; ++c6) {
                    const int chunk = tid + 512 * c6, key = chunk >> 3, c = chunk & 7, lk = base_l + key;
                    const bool ok = (lk >= 0 && lk < sub_len);
                    const size_t t = (size_t)(ok ? lk : 0) * dl + r;
                    u32x4 kv4 = *(const u32x4*)(zk + t * 4864 + 8 * c), vv4 = *(const u32x4*)(zv + t * 4864 + 8 * c);
                    if (!ok) { kv4 = (u32x4){0u, 0u, 0u, 0u}; vv4 = kv4; }
                    *(LAS u32x4*)(lds + key * KSTR + 16 * c) = kv4;
                    LAS bf16_t* vp = (LAS bf16_t*)(lds + VB + (8 * c) * VSTR + key * 2);
                    vp[0 * (VSTR / 2)] = (bf16_t)(vv4.x & 0xffffu); vp[1 * (VSTR / 2)] = (bf16_t)(vv4.x >> 16);
                    vp[2 * (VSTR / 2)] = (bf16_t)(vv4.y & 0xffffu); vp[3 * (VSTR / 2)] = (bf16_t)(vv4.y >> 16);
                    vp[4 * (VSTR / 2)] = (bf16_t)(vv4.z & 0xffffu); vp[5 * (VSTR / 2)] = (bf16_t)(vv4.z >> 16);
                    vp[6 * (VSTR / 2)] = (bf16_t)(vv4.w & 0xffffu); vp[7 * (VSTR / 2)] = (bf16_t)(vv4.w >> 16);
                }
                __syncthreads();
                const int b = wave >> 1, lq = 256 * q4 + 32 * wave + l32;
                const size_t tq = (size_t)lq * dl + r;
                bf16x8 qf[4];
#pragma unroll
                for (int s = 0; s < 4; ++s) qf[s] = *(const bf16x8*)(Z + tq * 4864 + (size_t)(g * 3) * 512 + h * 64 + 16 * s + 8 * hl);
                f32x16 o[2];
#pragma unroll
                for (int k = 0; k < 16; ++k) { o[0][k] = 0.f; o[1][k] = 0.f; }
                float m = -INFINITY, l = 0.f;
                const float slope2 = fexp2(-(float)(8 * g + h + 1) * (1.f / 3.f)) * (float)dl * LOG2E;
#pragma unroll 1
                for (int tt = 0; tt < 3; ++tt) {
                    const int j = b + tt, lk0 = base_l + 64 * j;
                    attn_tile<4>(lds + j * 64 * KSTR, KSTR, lds + VB + j * 128, VSTR, qf, o, m, l, l32, hl, [&](float v, int key) {
                        const int lk = lk0 + key, rel = lk - lq, a = rel < 0 ? -rel : rel;
                        const bool ok = (a <= 64) && (lk >= 0) && (lk < sub_len);
                        return ok ? v * cscale - slope2 * (float)a : -INFINITY; });
                }
                attn_store(OG + ((size_t)g * S + tq) * 512 + h * 64, o, 1.f / l, hl);
                if (hl == 0) LSE[((size_t)g * S + tq) * 8 + h] = m + __builtin_amdgcn_logf(l);
                __syncthreads();
            }
        } break;
        case K_MERGE: {
            for (int idx = bx * NTHREADS + tid; idx < S * 64; idx += G * NTHREADS) {
                const int t = idx >> 6, h = (idx >> 3) & 7, c = idx & 7;
                const float l0 = LSE[((size_t)0 * S + t) * 8 + h], l1 = LSE[((size_t)1 * S + t) * 8 + h], l2 = LSE[((size_t)2 * S + t) * 8 + h];
                const float mx = fmaxf(l0, fmaxf(l1, l2));
                float w0 = fexp2(l0 - mx), w1 = fexp2(l1 - mx), w2 = fexp2(l2 - mx);
                const float inv = 1.f / (w0 + w1 + w2); w0 *= inv; w1 *= inv; w2 *= inv;
                const u32x4 a0 = *(const u32x4*)(OG + ((size_t)0 * S + t) * 512 + h * 64 + 8 * c);
                const u32x4 a1 = *(const u32x4*)(OG + ((size_t)1 * S + t) * 512 + h * 64 + 8 * c);
                const u32x4 a2 = *(const u32x4*)(OG + ((size_t)2 * S + t) * 512 + h * 64 + 8 * c);
                u32x4 w;
                w.x = pk2(w0 * bflo(a0.x) + w1 * bflo(a1.x) + w2 * bflo(a2.x), w0 * bfhi(a0.x) + w1 * bfhi(a1.x) + w2 * bfhi(a2.x));
                w.y = pk2(w0 * bflo(a0.y) + w1 * bflo(a1.y) + w2 * bflo(a2.y), w0 * bfhi(a0.y) + w1 * bfhi(a1.y) + w2 * bfhi(a2.y));
                w.z = pk2(w0 * bflo(a0.z) + w1 * bflo(a1.z) + w2 * bflo(a2.z), w0 * bfhi(a0.z) + w1 * bfhi(a1.z) + w2 * bfhi(a2.z));
                w.w = pk2(w0 * bflo(a0.w) + w1 * bflo(a1.w) + w2 * bflo(a2.w), w0 * bfhi(a0.w) + w1 * bfhi(a1.w) + w2 * bfhi(a2.w));
                *(u32x4*)(CAT + (size_t)t * 768 + h * 64 + 8 * c) = w;
            }
        } break;
        case K_CONV: {
            const float* cw = (const float*)args.in[17]; const float* cb = (const float*)args.in[18];
            const float* lng = (const float*)args.in[19]; const float* lnb = (const float*)args.in[20];
            constexpr int RSTR = 1536, RED = 73728;
            LAS float* red = (LAS float*)(lds + RED);
            for (int u = bx; u < 1024; u += G) {
                const int t0 = 16 * u;
                int tl = tid; asm volatile("" : "+v"(tl));
                for (int chunk = tl; chunk < 46 * 96; chunk += NTHREADS) {
                    const int rr = chunk / 96, c = chunk - rr * 96, t = t0 - 15 + rr;
                    u32x4 v = {0u, 0u, 0u, 0u};
                    if (t >= 0 && t < S) v = *(const u32x4*)(Z + (size_t)t * 1024 + 8 * c);
                    *(LAS u32x4*)(lds + rr * RSTR + 16 * c) = v;
                }
                __syncthreads();
                int cgx = tid & 255; asm volatile("" : "+v"(cgx));
                const int th = wave >> 2;
                float v[3][8], s1[8], s2[8];
#pragma unroll
                for (int k = 0; k < 3; ++k) {
                    const int c = cgx + 256 * k;
                    float wj[31];
                    const float* cwp = cw + c; asm volatile("" : "+v"(cwp));
#pragma unroll
                    for (int j = 0; j < 31; ++j) wj[j] = cwp[j * 768];
                    const float bias = cb[c];
                    float acc[8];
#pragma unroll
                    for (int o = 0; o < 8; ++o) acc[o] = bias;
#pragma unroll
                    for (int i = 0; i < 38; ++i) {
                        const float xv = bf2f(*(const LAS bf16_t*)(lds + (th * 8 + i) * RSTR + 2 * c));
#pragma unroll
                        for (int o = 0; o < 8; ++o) { if (i - o >= 0 && i - o < 31) acc[o] += wj[i - o] * xv; }
                        if ((i & 7) == 7) asm volatile("" ::: "memory");
                    }
#pragma unroll
                    for (int o = 0; o < 8; ++o) v[k][o] = acc[o];
                    asm volatile("" ::: "memory");
                }
#pragma unroll
                for (int o = 0; o < 8; ++o) { s1[o] = (v[0][o] + v[1][o]) + v[2][o]; s2[o] = (v[0][o] * v[0][o] + v[1][o] * v[1][o]) + v[2][o] * v[2][o]; }
#pragma unroll
                for (int o = 0; o < 8; ++o) { s1[o] = wave_sum(s1[o]); s2[o] = wave_sum(s2[o]); }
                if (lane == 0) {
#pragma unroll
                    for (int o = 0; o < 8; ++o) { red[wave * 16 + o] = s1[o]; red[wave * 16 + 8 + o] = s2[o]; }
                }
                __syncthreads();
#pragma unroll
                for (int o = 0; o < 8; ++o) {
                    const float a = (red[(th * 4 + 0) * 16 + o] + red[(th * 4 + 1) * 16 + o]) + (red[(th * 4 + 2) * 16 + o] + red[(th * 4 + 3) * 16 + o]);
                    const float q = (red[(th * 4 + 0) * 16 + 8 + o] + red[(th * 4 + 1) * 16 + 8 + o]) + (red[(th * 4 + 2) * 16 + 8 + o] + red[(th * 4 + 3) * 16 + 8 + o]);
                    const float mean = a * (1.f / 768.f);
                    const float var = fmaxf(q * (1.f / 768.f) - mean * mean, 0.f);
                    s1[o] = mean; s2[o] = 1.f / sqrtf(var + EPS);
                }
#pragma unroll
                for (int k = 0; k < 3; ++k) {
                    const int c = cgx + 256 * k;
                    const float gg = lng[c], bb = lnb[c];
#pragma unroll
                    for (int o = 0; o < 8; ++o) {
                        const float yv = (v[k][o] - s1[o]) * s2[o] * gg + bb;
                        CAT[(size_t)(t0 + th * 8 + o) * 1024 + c] = (bf16_t)(pk2(silu_f(yv), 0.f) & 0xffffu);
                    }
                }
                __syncthreads();
            }
        } break;
        case K_SCONV: {
            const float* dw = (const float*)args.in[23];
            for (int idx = bx * NTHREADS + tid; idx < S * 96; idx += G * NTHREADS) {
                const int t = idx / 96, c = idx - t * 96;
                const bf16_t* zr = Z + (size_t)t * 1792;
                const u32x4 bg = *(const u32x4*)(zr + 8 * c);
                const u32x4 v0 = *(const u32x4*)(zr + 768 + 8 * c);
                u32x4 vm = {0u, 0u, 0u, 0u}, vp = {0u, 0u, 0u, 0u};
                if (t > 0) vm = *(const u32x4*)(zr - 1792 + 768 + 8 * c);
                if (t < S - 1) vp = *(const u32x4*)(zr + 1792 + 768 + 8 * c);
                const f32x4 wa0 = *(const f32x4*)(dw + 8 * c), wa1 = *(const f32x4*)(dw + 8 * c + 4);
                const f32x4 wb0 = *(const f32x4*)(dw + 768 + 8 * c), wb1 = *(const f32x4*)(dw + 768 + 8 * c + 4);
                const f32x4 wc0 = *(const f32x4*)(dw + 1536 + 8 * c), wc1 = *(const f32x4*)(dw + 1536 + 8 * c + 4);
                u32x4 w;
                w.x = pk2(bflo(bg.x) * (wa0[0] * bflo(vm.x) + wb0[0] * bflo(v0.x) + wc0[0] * bflo(vp.x)), bfhi(bg.x) * (wa0[1] * bfhi(vm.x) + wb0[1] * bfhi(v0.x) + wc0[1] * bfhi(vp.x)));
                w.y = pk2(bflo(bg.y) * (wa0[2] * bflo(vm.y) + wb0[2] * bflo(v0.y) + wc0[2] * bflo(vp.y)), bfhi(bg.y) * (wa0[3] * bfhi(vm.y) + wb0[3] * bfhi(v0.y) + wc0[3] * bfhi(vp.y)));
                w.z = pk2(bflo(bg.z) * (wa1[0] * bflo(vm.z) + wb1[0] * bflo(v0.z) + wc1[0] * bflo(vp.z)), bfhi(bg.z) * (wa1[1] * bfhi(vm.z) + wb1[1] * bfhi(v0.z) + wc1[1] * bfhi(vp.z)));
                w.w = pk2(bflo(bg.w) * (wa1[2] * bflo(vm.w) + wb1[2] * bflo(v0.w) + wc1[2] * bflo(vp.w)), bfhi(bg.w) * (wa1[3] * bfhi(vm.w) + wb1[3] * bfhi(v0.w) + wc1[3] * bfhi(vp.w)));
                *(u32x4*)(CAT + (size_t)t * 1024 + 8 * c) = w;
            }
        } break;
        default: break;
        }
        __syncthreads();
        if (dosync && opi + 1 < args.hi) {
            if (first_seam) { grid.sync(); first_seam = false; }
            else xcd_barrier(xbar, tid);
        }
    }
}

extern "C" void kernel_launch(void* const* d_in, const int* in_sizes, int n_in, void* d_out, int out_size, void* d_ws, size_t ws_size, hipStream_t stream) {
    static int grid = 0;
    if (grid == 0) {
        if (n_in != 25 || out_size != S * DM || ws_size < WS_END) { fprintf(stderr, "kernel_launch: unexpected shapes (n_in %d, out %d, ws %zu < %zu)\n", n_in, out_size, ws_size, (size_t)WS_END); grid = -1; return; }
        int dev = 0, cus = 0, per_cu = 0;
        if (hipGetDevice(&dev) != hipSuccess || hipDeviceGetAttribute(&cus, hipDeviceAttributeMultiprocessorCount, dev) != hipSuccess) { grid = -1; return; }
        if (hipFuncSetAttribute((const void*)fwd_megakernel, hipFuncAttributeMaxDynamicSharedMemorySize, LDS_BYTES) != hipSuccess) { fprintf(stderr, "kernel_launch: hipFuncSetAttribute failed\n"); grid = -1; return; }
        if (hipOccupancyMaxActiveBlocksPerMultiprocessor(&per_cu, (const void*)fwd_megakernel, NTHREADS, LDS_BYTES) != hipSuccess || per_cu < 1) { fprintf(stderr, "kernel_launch: occupancy query says %d\n", per_cu); per_cu = 1; }
        (void)hipGetLastError();
        grid = cus * per_cu;
    }
    if (grid < 0) return;
    if (hipMemsetAsync((unsigned char*)d_ws + WS_BAR, 0, 16384, stream) != hipSuccess) { fprintf(stderr, "kernel_launch: memset of the barrier words failed\n"); return; }
    Args a{};
    for (int i = 0; i < 25; ++i) a.in[i] = d_in[i];
    a.out = (float*)d_out; a.ws = (unsigned char*)d_ws;
#if MK_MULTI_LAUNCH
    int lo = 0;
    for (int i = 0; i < H_OPS.n; ++i) {
        if ((H_OPS.v[i] >> 24) & 1u) { a.lo = lo; a.hi = i + 1; hipLaunchKernelGGL(fwd_megakernel, dim3(grid), dim3(NTHREADS), LDS_BYTES, stream, a); lo = i + 1; }
    }
#else
    a.lo = 0; a.hi = H_OPS.n;
    void* kargs[] = {&a};
    hipError_t e = hipLaunchCooperativeKernel((const void*)fwd_megakernel, dim3(grid), dim3(NTHREADS), kargs, LDS_BYTES, stream);
    if (e != hipSuccess) fprintf(stderr, "cooperative launch failed: %s (grid %d)\n", hipGetErrorString(e), grid);
#endif
}
```
